# Optimizing an MI355X kernel written in HIP

```python
import jax, jax.numpy as jnp
from jax import lax
import numpy as np

D_MODEL = 1024
BATCH = 32
SEQ = 256
DEPTH = 1
DEC_BATCH = 4
DEC_SEQ = 2048
PAST_LEN = 512

GRID_W = 64
H_A = 8
DK = 64
DV = 64
W_A = H_A * DV
W_B = 512
CONV_W = 3
CHUNK = 64
D_FF = ((8 * D_MODEL // 3 + 255) // 256) * 256
N_IN = 3 * H_A * DK + W_A + 2 * H_A + 2 * H_A + 3 * W_B + 2 * D_MODEL
SPLITS = tuple(np.cumsum([3 * H_A * DK, W_A, 2 * H_A, 2 * H_A, 3 * W_B]).tolist())
EPS = 1e-6

kernel_name = "hybrid_deltanet_shortconv_diffusion_step"


def rms_norm(x, g):
    xf = x.astype(jnp.float32)
    y = xf * lax.rsqrt(jnp.mean(xf * xf, axis=-1, keepdims=True) + EPS)
    return (y * g.astype(jnp.float32)).astype(x.dtype)


def l2norm(t):
    return t * lax.rsqrt(jnp.sum(t * t, axis=-1, keepdims=True) + EPS)


def conv_centred(x, w, n_rows):
    b, t, ch = x.shape
    xr = x.reshape(b * n_rows, t // n_rows, ch)
    y = lax.conv_general_dilated(xr, w[:, None, :].astype(x.dtype), window_strides=(1,),
                                 padding=((CONV_W // 2, CONV_W // 2),),
                                 dimension_numbers=('NWC', 'WIO', 'NWC'),
                                 feature_group_count=ch)
    return y.reshape(b, t, ch)


def gated_delta_chunked(q, k, v, beta, g, s0):
    b, h, t, _ = q.shape
    n = t // CHUNK
    rs = lambda a: a.reshape(b, h, n, CHUNK, *a.shape[3:])
    q, k, v, beta, g = rs(q), rs(k), rs(v), rs(beta), rs(g)
    g = jnp.cumsum(g, axis=-1)
    tri_incl = jnp.tril(jnp.ones((CHUNK, CHUNK), bool))
    tri_strict = jnp.tril(jnp.ones((CHUNK, CHUNK), bool), -1)
    diff = g[..., :, None] - g[..., None, :]
    decay = jnp.where(tri_incl, jnp.exp(jnp.where(tri_incl, diff, 0.0)), 0.0)
    kb = k * beta[..., None]
    lower = jnp.where(tri_strict, jnp.einsum('bhncd,bhned->bhnce', kb, k) * decay, 0.0)
    eye = jnp.eye(CHUNK, dtype=jnp.float32)
    tmat = lax.linalg.triangular_solve(eye + lower, jnp.broadcast_to(eye, lower.shape),
                                       left_side=True, lower=True)
    u = jnp.einsum('bhnce,bhned->bhncd', tmat, v * beta[..., None])
    w = jnp.einsum('bhnce,bhned->bhncd', tmat, kb * jnp.exp(g)[..., None])
    attn = jnp.where(tri_incl, jnp.einsum('bhncd,bhned->bhnce', q, k) * decay, 0.0)
    g_last = g[..., -1]
    k_tail = k * jnp.exp(g_last[..., None] - g)[..., None]
    q_head = q * jnp.exp(g)[..., None]

    def step(s, xs):
        q_c, w_c, u_c, a_c, k_c, gl = xs
        v_new = u_c - jnp.einsum('bhcd,bhde->bhce', w_c, s)
        o = jnp.einsum('bhcd,bhde->bhce', q_c, s) + jnp.einsum('bhce,bhed->bhcd', a_c, v_new)
        s = s * jnp.exp(gl)[..., None, None] + jnp.einsum('bhcd,bhce->bhde', k_c, v_new)
        return s, o

    mv = lambda a: jnp.moveaxis(a, 2, 0)
    s_fin, o = lax.scan(step, s0, (mv(q_head), mv(w), mv(u), mv(attn), mv(k_tail), mv(g_last)))
    o = jnp.moveaxis(o, 0, 2).reshape(b, h, t, -1)
    return o, s_fin


def mixing(h, s0, n_rows, w_in, conv_qkv, a_log, dt_bias, onorm, conv_sc, w_br_a, w_br_b, w_out):
    b, t, _ = h.shape
    p = h @ w_in
    qkv, z, beta, a, sc, gates = jnp.split(p, SPLITS, axis=-1)
    qkv = jax.nn.silu(conv_centred(qkv, conv_qkv, n_rows))
    q, k, v = jnp.split(qkv, 3, axis=-1)
    heads = lambda x, d: x.reshape(b, t, H_A, d).transpose(0, 2, 1, 3).astype(jnp.float32)
    q = l2norm(heads(q, DK)) * (DK ** -0.5)
    k = l2norm(heads(k, DK))
    v = heads(v, DV)
    dirs = lambda x: x.astype(jnp.float32).reshape(b, t, 2, H_A).transpose(2, 0, 3, 1)
    beta = jax.nn.sigmoid(dirs(beta))
    g = -jnp.exp(a_log.astype(jnp.float32))[:, None, :, None] * jax.nn.softplus(
        dirs(a) + dt_bias.astype(jnp.float32)[:, None, :, None])
    s0 = s0.astype(jnp.float32)
    o_f, s_f = gated_delta_chunked(q, k, v, beta[0], g[0], s0[:, 0])
    fl = lambda x: jnp.flip(x, axis=2)
    o_b, s_b = gated_delta_chunked(fl(q), fl(k), fl(v), fl(beta[1]), fl(g[1]), s0[:, 1])
    o = (o_f + fl(o_b)).transpose(0, 2, 1, 3)
    o = o * lax.rsqrt(jnp.mean(o * o, axis=-1, keepdims=True) + EPS) * onorm.astype(jnp.float32)
    o = (o * jax.nn.silu(z.astype(jnp.float32).reshape(b, t, H_A, DV))).reshape(b, t, W_A)
    y_a = o.astype(h.dtype) @ w_br_a
    bg, cg, xs = jnp.split(sc, 3, axis=-1)
    y_b = (bg * conv_centred(cg * xs, conv_sc, n_rows)) @ w_br_b
    ga, gb = jnp.split(gates, 2, axis=-1)
    m = jax.nn.sigmoid(ga) * y_a + jax.nn.sigmoid(gb) * y_b
    return m @ w_out, jnp.stack([s_f, s_b], axis=1)


def layer(x, mod, s0, n_rows, norm_gains, w_in, conv_qkv, a_log, dt_bias, onorm, conv_sc,
          w_br_a, w_br_b, w_out, w_ffn_in, w_ffn_out):
    sh1, sc1, gt1, sh2, sc2, gt2 = jnp.split(mod[:, None, :], 6, axis=-1)
    h = rms_norm(x, norm_gains[0]) * (1 + sc1) + sh1
    y, s_fin = mixing(h, s0, n_rows, w_in, conv_qkv, a_log, dt_bias, onorm, conv_sc,
                      w_br_a, w_br_b, w_out)
    x = x + gt1 * rms_norm(y, norm_gains[1])
    h = rms_norm(x, norm_gains[2]) * (1 + sc2) + sh2
    gate, up = jnp.split(h @ w_ffn_in, 2, axis=-1)
    y = (jax.nn.silu(gate) * up) @ w_ffn_out
    x = x + gt2 * rms_norm(y, norm_gains[3])
    return x, s_fin


def setup_inputs(seed: int = 0) -> dict:
    key = jax.random.key(seed)
    ks = jax.random.split(key, 20)
    nrm = lambda k, shape, s: jax.random.normal(k, shape, jnp.float32) * s
    dt = jnp.exp(jax.random.uniform(ks[10], (DEPTH, 2, H_A), jnp.float32,
                                    np.log(1e-3), np.log(1e-1)))
    return {
        "x_prompt": nrm(ks[0], (BATCH, SEQ, D_MODEL), 1.0),
        "x_sample": nrm(ks[1], (DEC_BATCH, DEC_SEQ, D_MODEL), 1.0),
        "state_delta": nrm(ks[2], (DEC_BATCH, DEPTH, 2, H_A, DK, DV), 0.05),
        "c": nrm(ks[3], (DEC_BATCH, D_MODEL), 1.0),
        "c_ctx": nrm(ks[4], (D_MODEL,), 1.0),
        "w_mod": nrm(ks[5], (DEPTH, D_MODEL, 6 * D_MODEL), 0.5 * D_MODEL ** -0.5),
        "b_mod": nrm(ks[6], (DEPTH, 6 * D_MODEL), 0.02),
        "norm_gains": 1.0 + nrm(ks[7], (DEPTH, 4, D_MODEL), 0.02),
        "w_in": nrm(ks[8], (DEPTH, D_MODEL, N_IN), D_MODEL ** -0.5),
        "conv_qkv": nrm(ks[9], (DEPTH, CONV_W, 3 * H_A * DK), CONV_W ** -0.5),
        "a_log": jnp.log(jax.random.uniform(ks[11], (DEPTH, 2, H_A), jnp.float32, 1.0, 16.0)),
        "dt_bias": dt + jnp.log(-jnp.expm1(-dt)),
        "onorm": 1.0 + nrm(ks[12], (DEPTH, DV), 0.02),
        "conv_sc": nrm(ks[13], (DEPTH, CONV_W, W_B), CONV_W ** -0.5),
        "w_branch_a": nrm(ks[14], (DEPTH, W_A, D_MODEL), W_A ** -0.5),
        "w_branch_b": nrm(ks[15], (DEPTH, W_B, D_MODEL), W_B ** -0.5),
        "w_out": nrm(ks[16], (DEPTH, D_MODEL, D_MODEL), D_MODEL ** -0.5),
        "w_ffn_in": nrm(ks[17], (DEPTH, D_MODEL, 2 * D_FF), D_MODEL ** -0.5),
        "w_ffn_out": nrm(ks[18], (DEPTH, D_FF, D_MODEL), D_FF ** -0.5),
    }


def reference(x_prompt, x_sample, state_delta, c, c_ctx, w_mod, b_mod, norm_gains, w_in,
              conv_qkv, a_log, dt_bias, onorm, conv_sc, w_branch_a, w_branch_b, w_out,
              w_ffn_in, w_ffn_out):
    rows = x_sample.shape[1] // GRID_W
    y_p = x_prompt
    s_zero = jnp.zeros((x_prompt.shape[0], 2, H_A, DK, DV), jnp.float32)
    new_states = []
    for l in range(DEPTH):
        mod_ctx = (jax.nn.silu(c_ctx) @ w_mod[l] + b_mod[l])[None, :]
        y_p, s_fin = layer(y_p, mod_ctx, s_zero, 1, norm_gains[l], w_in[l], conv_qkv[l],
                           a_log[l], dt_bias[l], onorm[l], conv_sc[l], w_branch_a[l],
                           w_branch_b[l], w_out[l], w_ffn_in[l], w_ffn_out[l])
        new_states.append(s_fin)
    new_state_delta = jnp.stack(new_states, axis=1).astype(x_prompt.dtype)
    y_s = x_sample
    for l in range(DEPTH):
        mod_lat = jax.nn.silu(c) @ w_mod[l] + b_mod[l]
        y_s, _ = layer(y_s, mod_lat, state_delta[:, l], rows, norm_gains[l], w_in[l],
                       conv_qkv[l], a_log[l], dt_bias[l], onorm[l], conv_sc[l],
                       w_branch_a[l], w_branch_b[l], w_out[l], w_ffn_in[l], w_ffn_out[l])
    return (y_p, y_s, new_state_delta)
```

```cpp
#include <hip/hip_runtime.h>
#include <cstdio>
#include <cstdint>

typedef unsigned short bf16;
__device__ __forceinline__ float bf2f(bf16 b) { return __uint_as_float(((unsigned)b) << 16); }
__device__ __forceinline__ bf16 f2bf(float f) { unsigned u = __float_as_uint(f); u += 0x7fffu + ((u >> 16) & 1u); return (bf16)(u >> 16); }
__device__ __forceinline__ float wave_sum(float v) {
#pragma unroll
    for (int o = 1; o < 64; o <<= 1) v += __shfl_xor(v, o);
    return v;
}
__device__ __forceinline__ float siluf(float x) { return x / (1.f + __expf(-x)); }
__device__ __forceinline__ float sigmf(float x) { return 1.f / (1.f + __expf(-x)); }
__device__ __forceinline__ float softplusf(float x) { return x > 20.f ? x : log1pf(__expf(x)); }

constexpr int D = 1024, MT = 16384, NCTX = 8192, NIN = 5664, DFF = 2816;
constexpr float EPS = 1e-6f;

__device__ __forceinline__ int mod_index(int r) { return r < NCTX ? 0 : 1 + (r - NCTX) / 2048; }

__global__ __launch_bounds__(256) void k_mod(const float* c, const float* c_ctx, const float* w_mod, const float* b_mod, float* mod) {
    const int n = blockIdx.x * 256 + threadIdx.x;
    float acc[5] = {0, 0, 0, 0, 0};
    for (int k = 0; k < D; ++k) {
        const float w = w_mod[(size_t)k * 6144 + n];
        acc[0] += siluf(c_ctx[k]) * w;
#pragma unroll
        for (int b = 0; b < 4; ++b) acc[1 + b] += siluf(c[b * D + k]) * w;
    }
#pragma unroll
    for (int r = 0; r < 5; ++r) mod[r * 6144 + n] = acc[r] + b_mod[n];
}

__global__ __launch_bounds__(256) void k_norm_mod(const float* xp, const float* xs, const float* gains, const float* mod, bf16* H) {
    const int r = blockIdx.x * 4 + (threadIdx.x >> 6), lane = threadIdx.x & 63;
    const float* x = r < NCTX ? xp + (size_t)r * D : xs + (size_t)(r - NCTX) * D;
    const float* m = mod + mod_index(r) * 6144;
    float v[16]; float s = 0.f;
#pragma unroll
    for (int j = 0; j < 16; ++j) { v[j] = x[lane + 64 * j]; s += v[j] * v[j]; }
    const float rstd = rsqrtf(wave_sum(s) * (1.f / D) + EPS);
#pragma unroll
    for (int j = 0; j < 16; ++j) { const int k = lane + 64 * j; H[(size_t)r * D + k] = f2bf(v[j] * rstd * gains[k] * (1.f + m[1024 + k]) + m[k]); }
}

template <int EPI>
__global__ __launch_bounds__(256) void k_gemm(const bf16* A, int lda, const float* W, int ldw, int M, int N, int K, void* Cout, int ldc, const bf16* G, int ldg, const float* Cacc) {
    __shared__ float As[16][65];
    __shared__ float Bs[16][65];
    const int tx = threadIdx.x & 15, ty = threadIdx.x >> 4;
    const int m0 = blockIdx.y * 64, n0 = blockIdx.x * 64;
    float acc[4][4];
#pragma unroll
    for (int i = 0; i < 4; ++i)
#pragma unroll
        for (int j = 0; j < 4; ++j) acc[i][j] = 0.f;
    for (int k0 = 0; k0 < K; k0 += 16) {
#pragma unroll
        for (int i = 0; i < 4; ++i) { const int e = threadIdx.x + 256 * i, rr = e >> 4, kk = e & 15; As[kk][rr] = bf2f(A[(size_t)(m0 + rr) * lda + k0 + kk]); }
#pragma unroll
        for (int i = 0; i < 4; ++i) { const int e = threadIdx.x + 256 * i, kk = e >> 6, cc = e & 63; Bs[kk][cc] = (n0 + cc < N) ? W[(size_t)(k0 + kk) * ldw + n0 + cc] : 0.f; }
        __syncthreads();
#pragma unroll
        for (int kk = 0; kk < 16; ++kk) {
            float a[4], b[4];
#pragma unroll
            for (int i = 0; i < 4; ++i) { a[i] = As[kk][ty * 4 + i]; b[i] = Bs[kk][tx * 4 + i]; }
#pragma unroll
            for (int i = 0; i < 4; ++i)
#pragma unroll
                for (int j = 0; j < 4; ++j) acc[i][j] += a[i] * b[j];
        }
        __syncthreads();
    }
#pragma unroll
    for (int i = 0; i < 4; ++i)
#pragma unroll
        for (int j = 0; j < 4; ++j) {
            const int r = m0 + ty * 4 + i, cidx = n0 + tx * 4 + j;
            if (cidx >= N) continue;
            if (EPI == 0) ((float*)Cout)[(size_t)r * ldc + cidx] = acc[i][j];
            if (EPI == 1) ((bf16*)Cout)[(size_t)r * ldc + cidx] = f2bf(acc[i][j]);
            if (EPI == 2) ((float*)Cout)[(size_t)r * ldc + cidx] = sigmf(bf2f(G[(size_t)r * ldg + cidx])) * acc[i][j];
            if (EPI == 3) ((bf16*)Cout)[(size_t)r * ldc + cidx] = f2bf(Cacc[(size_t)r * ldc + cidx] + sigmf(bf2f(G[(size_t)r * ldg + cidx])) * acc[i][j]);
        }
}

__global__ __launch_bounds__(64) void k_delta_naive(const bf16* QKV, const float* BA, const float* conv_qkv, const float* a_log, const float* dt_bias,
                                                    const float* state_delta, float* O, float* out_state, int dir) {
    const int s = blockIdx.x, lane = threadIdx.x;
    const bool ctx = s < 256;
    const int sl = ctx ? s : s - 256, b = sl >> 3, h = sl & 7;
    const int T = ctx ? 256 : 2048, row0 = ctx ? b * 256 : NCTX + b * 2048, seglen = ctx ? 256 : 64;
    float S[64];
#pragma unroll
    for (int dk = 0; dk < 64; ++dk) S[dk] = ctx ? 0.f : state_delta[((size_t)(b * 2 + dir) * 8 + h) * 4096 + dk * 64 + lane];
    const float Aexp = __expf(a_log[dir * 8 + h]), dtb = dt_bias[dir * 8 + h];
    float wq[3], wk[3], wv[3];
#pragma unroll
    for (int j = 0; j < 3; ++j) { wq[j] = conv_qkv[j * 1536 + h * 64 + lane]; wk[j] = conv_qkv[j * 1536 + 512 + h * 64 + lane]; wv[j] = conv_qkv[j * 1536 + 1024 + h * 64 + lane]; }
    for (int step = 0; step < T; ++step) {
        const int t = dir ? T - 1 - step : step, r = row0 + t, pos = t % seglen;
        float q = 0.f, k = 0.f, v = 0.f;
#pragma unroll
        for (int j = 0; j < 3; ++j) {
            const int pp = pos + j - 1;
            if (pp >= 0 && pp < seglen) {
                const bf16* p = QKV + (size_t)(r + j - 1) * 1536 + h * 64 + lane;
                q += wq[j] * bf2f(p[0]); k += wk[j] * bf2f(p[512]); v += wv[j] * bf2f(p[1024]);
            }
        }
        q = siluf(q); k = siluf(k); v = siluf(v);
        q = q * rsqrtf(wave_sum(q * q) + EPS) * 0.125f;
        k = k * rsqrtf(wave_sum(k * k) + EPS);
        const float beta = sigmf(BA[(size_t)r * 32 + dir * 8 + h]);
        const float g = -Aexp * softplusf(BA[(size_t)r * 32 + 16 + dir * 8 + h] + dtb);
        const float a = __expf(g);
        float kS = 0.f;
#pragma unroll
        for (int dk = 0; dk < 64; ++dk) kS += __shfl(k, dk) * S[dk];
        const float cc = beta * (v - a * kS);
        float o = 0.f;
#pragma unroll
        for (int dk = 0; dk < 64; ++dk) { S[dk] = a * S[dk] + __shfl(k, dk) * cc; o += __shfl(q, dk) * S[dk]; }
        float* op = O + (size_t)r * 512 + h * 64 + lane;
        if (dir) *op += o; else *op = o;
    }
    if (ctx) {
#pragma unroll
        for (int dk = 0; dk < 64; ++dk) out_state[((size_t)(b * 2 + dir) * 8 + h) * 4096 + dk * 64 + lane] = S[dk];
    }
}

__global__ __launch_bounds__(256) void k_ob(const bf16* SC, const float* conv_sc, bf16* OB) {
    const size_t idx = (size_t)blockIdx.x * 256 + threadIdx.x;
    const int r = (int)(idx >> 9), j = (int)(idx & 511);
    const int seglen = r < NCTX ? 256 : 64, pos = r % seglen;
    float acc = 0.f;
#pragma unroll
    for (int tp = 0; tp < 3; ++tp) {
        const int pp = pos + tp - 1;
        if (pp >= 0 && pp < seglen) { const bf16* p = SC + (size_t)(r + tp - 1) * 1536; acc += conv_sc[tp * 512 + j] * bf2f(p[512 + j]) * bf2f(p[1024 + j]); }
    }
    OB[idx] = f2bf(bf2f(SC[(size_t)r * 1536 + j]) * acc);
}

__global__ __launch_bounds__(256) void k_oa(const float* O, const bf16* Z, const float* onorm, bf16* OA) {
    const int r = blockIdx.x * 4 + (threadIdx.x >> 6), lane = threadIdx.x & 63;
#pragma unroll
    for (int h = 0; h < 8; ++h) {
        const float o = O[(size_t)r * 512 + h * 64 + lane];
        const float rs = rsqrtf(wave_sum(o * o) * (1.f / 64.f) + EPS);
        OA[(size_t)r * 512 + h * 64 + lane] = f2bf(o * rs * onorm[lane] * siluf(bf2f(Z[(size_t)r * 512 + h * 64 + lane])));
    }
}

__global__ __launch_bounds__(256) void k_res_norm(const float* xp, const float* xs, const float* MIX, const float* gains, const float* mod, float* out, bf16* H) {
    const int r = blockIdx.x * 4 + (threadIdx.x >> 6), lane = threadIdx.x & 63;
    const float* x = r < NCTX ? xp + (size_t)r * D : xs + (size_t)(r - NCTX) * D;
    const float* m = mod + mod_index(r) * 6144;
    float v[16]; float s = 0.f;
#pragma unroll
    for (int j = 0; j < 16; ++j) { v[j] = MIX[(size_t)r * D + lane + 64 * j]; s += v[j] * v[j]; }
    const float rstd = rsqrtf(wave_sum(s) * (1.f / D) + EPS);
    float s2 = 0.f;
#pragma unroll
    for (int j = 0; j < 16; ++j) { const int k = lane + 64 * j; v[j] = x[k] + m[2048 + k] * (v[j] * rstd * gains[1024 + k]); s2 += v[j] * v[j]; out[(size_t)r * D + k] = v[j]; }
    const float rstd2 = rsqrtf(wave_sum(s2) * (1.f / D) + EPS);
#pragma unroll
    for (int j = 0; j < 16; ++j) { const int k = lane + 64 * j; H[(size_t)r * D + k] = f2bf(v[j] * rstd2 * gains[2048 + k] * (1.f + m[4096 + k]) + m[3072 + k]); }
}

__global__ __launch_bounds__(256) void k_swiglu(bf16* GU) {
    const size_t idx = (size_t)blockIdx.x * 256 + threadIdx.x;
    const size_t r = idx / DFF; const int j = (int)(idx % DFF);
    bf16* p = GU + r * (2 * DFF);
    p[j] = f2bf(siluf(bf2f(p[j])) * bf2f(p[DFF + j]));
}

__global__ __launch_bounds__(256) void k_final(const float* Y, const float* gains, const float* mod, float* out) {
    const int r = blockIdx.x * 4 + (threadIdx.x >> 6), lane = threadIdx.x & 63;
    const float* m = mod + mod_index(r) * 6144;
    float v[16]; float s = 0.f;
#pragma unroll
    for (int j = 0; j < 16; ++j) { v[j] = Y[(size_t)r * D + lane + 64 * j]; s += v[j] * v[j]; }
    const float rstd = rsqrtf(wave_sum(s) * (1.f / D) + EPS);
#pragma unroll
    for (int j = 0; j < 16; ++j) { const int k = lane + 64 * j; out[(size_t)r * D + k] += m[5120 + k] * (v[j] * rstd * gains[3072 + k]); }
}

extern "C" void kernel_launch(void* const* d_in, const int* in_sizes, int n_in, void* d_out, int out_size, void* d_ws, size_t ws_size, hipStream_t stream) {
    const float* x_prompt = (const float*)d_in[0]; const float* x_sample = (const float*)d_in[1]; const float* state_delta = (const float*)d_in[2];
    const float* c = (const float*)d_in[3]; const float* c_ctx = (const float*)d_in[4]; const float* w_mod = (const float*)d_in[5]; const float* b_mod = (const float*)d_in[6];
    const float* gains = (const float*)d_in[7]; const float* w_in = (const float*)d_in[8]; const float* conv_qkv = (const float*)d_in[9]; const float* a_log = (const float*)d_in[10];
    const float* dt_bias = (const float*)d_in[11]; const float* onorm = (const float*)d_in[12]; const float* conv_sc = (const float*)d_in[13]; const float* w_bra = (const float*)d_in[14];
    const float* w_brb = (const float*)d_in[15]; const float* w_out = (const float*)d_in[16]; const float* w_ffn_in = (const float*)d_in[17]; const float* w_ffn_out = (const float*)d_in[18];
    float* out = (float*)d_out; float* out_state = out + (size_t)MT * D;
    char* ws = (char*)d_ws;
    constexpr size_t R0 = 0, SZ_QKV = (size_t)MT * 1536 * 2, R1 = R0 + SZ_QKV, SZ_Z = (size_t)MT * 512 * 2, R2 = R1 + SZ_Z, SZ_SC = SZ_QKV, R3 = R2 + SZ_SC, SZ_G = (size_t)MT * 2048 * 2,
                     R4 = R3 + SZ_G, SZ_BA = (size_t)MT * 32 * 4, R5 = R4 + SZ_BA, SZ_H = (size_t)MT * D * 2, R6 = R5 + SZ_H, SZ_O = (size_t)MT * 512 * 4, R7 = R6 + SZ_O, SZ_MOD = 5 * 6144 * 4, REND = R7 + SZ_MOD;
    if (ws_size < REND) { fprintf(stderr, "kernel_launch: workspace too small: %zu < %zu\n", ws_size, (size_t)REND); return; }
    bf16* QKV = (bf16*)(ws + R0); bf16* Z = (bf16*)(ws + R1); bf16* SC = (bf16*)(ws + R2); bf16* GATES = (bf16*)(ws + R3); float* BA = (float*)(ws + R4);
    bf16* H = (bf16*)(ws + R5); float* O = (float*)(ws + R6); float* mod = (float*)(ws + R7);
    bf16* OB = (bf16*)(ws + R5); bf16* OA = (bf16*)(ws + R2); float* YA = (float*)(ws + R0); bf16* Mb = (bf16*)(ws + R6); float* MIX = (float*)(ws + R0);
    bf16* H2 = (bf16*)(ws + R5); bf16* GU = (bf16*)(ws + R0); float* Y = (float*)(ws + R5);

    k_mod<<<6144 / 256, 256, 0, stream>>>(c, c_ctx, w_mod, b_mod, mod);
    k_norm_mod<<<MT / 4, 256, 0, stream>>>(x_prompt, x_sample, gains, mod, H);
    k_gemm<1><<<dim3(1536 / 64, MT / 64), 256, 0, stream>>>(H, D, w_in + 0, NIN, MT, 1536, D, QKV, 1536, nullptr, 0, nullptr);
    k_gemm<1><<<dim3(512 / 64, MT / 64), 256, 0, stream>>>(H, D, w_in + 1536, NIN, MT, 512, D, Z, 512, nullptr, 0, nullptr);
    k_gemm<0><<<dim3(1, MT / 64), 256, 0, stream>>>(H, D, w_in + 2048, NIN, MT, 32, D, BA, 32, nullptr, 0, nullptr);
    k_gemm<1><<<dim3(1536 / 64, MT / 64), 256, 0, stream>>>(H, D, w_in + 2080, NIN, MT, 1536, D, SC, 1536, nullptr, 0, nullptr);
    k_gemm<1><<<dim3(2048 / 64, MT / 64), 256, 0, stream>>>(H, D, w_in + 3616, NIN, MT, 2048, D, GATES, 2048, nullptr, 0, nullptr);
    k_delta_naive<<<288, 64, 0, stream>>>(QKV, BA, conv_qkv, a_log, dt_bias, state_delta, O, out_state, 0);
    k_delta_naive<<<288, 64, 0, stream>>>(QKV, BA, conv_qkv, a_log, dt_bias, state_delta, O, out_state, 1);
    k_ob<<<(MT * 512) / 256, 256, 0, stream>>>(SC, conv_sc, OB);
    k_oa<<<MT / 4, 256, 0, stream>>>(O, Z, onorm, OA);
    k_gemm<2><<<dim3(D / 64, MT / 64), 256, 0, stream>>>(OA, 512, w_bra, D, MT, D, 512, YA, D, GATES, 2048, nullptr);
    k_gemm<3><<<dim3(D / 64, MT / 64), 256, 0, stream>>>(OB, 512, w_brb, D, MT, D, 512, Mb, D, GATES + 1024, 2048, YA);
    k_gemm<0><<<dim3(D / 64, MT / 64), 256, 0, stream>>>(Mb, D, w_out, D, MT, D, D, MIX, D, nullptr, 0, nullptr);
    k_res_norm<<<MT / 4, 256, 0, stream>>>(x_prompt, x_sample, MIX, gains, mod, out, H2);
    k_gemm<1><<<dim3(2 * DFF / 64, MT / 64), 256, 0, stream>>>(H2, D, w_ffn_in, 2 * DFF, MT, 2 * DFF, D, GU, 2 * DFF, nullptr, 0, nullptr);
    k_swiglu<<<(unsigned)(((size_t)MT * DFF) / 256), 256, 0, stream>>>(GU);
    k_gemm<0><<<dim3(D / 64, MT / 64), 256, 0, stream>>>(GU, 2 * DFF, w_ffn_out, D, MT, D, DFF, Y, D, nullptr, 0, nullptr);
    k_final<<<MT / 4, 256, 0, stream>>>(Y, gains, mod, out);
}
```

```cpp
#include <hip/hip_runtime.h>
#include <cstdio>
#include <cstdint>
namespace pg8 {
#define PG8_LAS __attribute__((address_space(3)))
typedef unsigned short bf16_t;
typedef short bf16x8 __attribute__((ext_vector_type(8)));
typedef float f32x4 __attribute__((ext_vector_type(4)));
typedef unsigned u32x4 __attribute__((ext_vector_type(4)));
constexpr int BM = 256, BK = 64, HALF = 128, HTB = HALF * BK * 2  , STAGE_BYTES = 8 * HTB, NXCD = 8, WGM = 8;

__host__ __device__ __forceinline__ int lds_byte(int r, int c) { const int st = (r >> 4) * 2 + (c >> 5), rr = r & 15, cc = c & 31, ob = rr * 64 + cc * 2; return st * 1024 + (ob ^ (((ob >> 9) & 1) << 5)); }
__host__ __device__ __forceinline__ void stage_rc(int b, int& R, int& C) { const int st = b / 1024, sb = b % 1024, swz = sb ^ (((sb >> 9) & 1) << 5); R = (st >> 1) * 16 + swz / 64; C = (st & 1) * 32 + (swz % 64) / 2; }
__host__ __device__ __forceinline__ int perm32(int rho) { const int n = rho >> 4, i = rho & 15; return 8 * (i >> 2) + 4 * n + (i & 3); }

struct Unit { int pm, pn; };
struct Gemm { const bf16_t* A; const bf16_t* Bt; int M, N, K; };

struct StaticOrder {
    int nM, nN, nwg, G, c;
    __host__ __device__ void init(int M, int N, int G_, int c_) { nM = M / BM; nN = N / BM; nwg = nM * nN; G = G_; c = c_; }
    __host__ __device__ bool next(int i, Unit& u) const {
        const long L = (long)i * G + c; if (L >= nwg) return false;
        int wgid = (int)L; { const int q = nwg / NXCD, r = nwg % NXCD, xcd = wgid % NXCD, off = wgid / NXCD; wgid = (xcd < r ? xcd * (q + 1) : r * (q + 1) + (xcd - r) * q) + off; }
        const int nig = WGM * nN, gid = wgid / nig, fm = gid * WGM, gsz = (nM - fm) < WGM ? (nM - fm) : WGM;
        u.pm = fm + ((wgid % nig) % gsz); u.pn = (wgid % nig) / gsz; return true;
    }
    __device__ __forceinline__ void a_ready(const Unit&) const {}
    __device__ __forceinline__ void done(const Unit&) const {}
};

__device__ __forceinline__ unsigned cvt_pk_bf16(float lo, float hi) { unsigned r; asm volatile("v_cvt_pk_bf16_f32 %0, %1, %2" : "=v"(r) : "v"(lo), "v"(hi)); return r; }
typedef float f32x2 __attribute__((ext_vector_type(2)));
template <class Epi, class Sched, bool ALIGN_EPI = false, bool SP2 = false>
__device__ __forceinline__ void gemm_phase(PG8_LAS unsigned char* lds, const Gemm g, const Sched& S, const Epi& E, const int wid_in) {
    int lane_l; asm volatile("v_mbcnt_lo_u32_b32 %0, -1, 0\n\tv_mbcnt_hi_u32_b32 %0, -1, %0" : "=v"(lane_l));
    const int tid = wid_in * 64 + lane_l, wid = wid_in, lane = tid & 63, wr = wid >> 2, wc = wid & 3, fr = lane & 15, fq = lane >> 4;
    const int K = g.K, nt = K / BK;
    unsigned voffA[2], voffB[2];
#pragma unroll
    for (int i = 0; i < 2; ++i) { int R, C; stage_rc(tid * 16 + i * 8192, R, C); const int Rb = Epi::PERM ? ((R & ~31) + perm32(R & 31)) : R;
        voffA[i] = (unsigned)(R * K + C) * 2u; voffB[i] = (unsigned)(Rb * K + C) * 2u; }
    const size_t kstep = (size_t)(BK * 2);
    const size_t hstep = (size_t)HALF * K * 2;
    const size_t tstep = 2 * hstep;
    const unsigned ldsw = (unsigned)wid * 1024u;
    const int aoff = lds_byte(wr * 64 + fr, fq * 8), boff = lds_byte(wc * 32 + fr, fq * 8);
#define PG8_SA(b, h) (((b) * 2 + (h)) * HTB)
#define PG8_SB(b, h) ((4 + (b) * 2 + (h)) * HTB)
#define PG8_STAGE(bufoff, gbase, voff) do { _Pragma("unroll") for (int _i = 0; _i < 2; ++_i) \
        __builtin_amdgcn_global_load_lds((const unsigned*)((const char*)(gbase) + (voff)[_i]), (PG8_LAS unsigned*)(lds + (bufoff) + ldsw + _i * 8192), 16, 0, 0); } while (0)
#define PG8_LDA(dst, b, h) do { _Pragma("unroll") for (int m = 0; m < 4; ++m) _Pragma("unroll") for (int k = 0; k < 2; ++k) dst[m][k] = *(const PG8_LAS bf16x8*)(lds + PG8_SA(b, h) + aoff + m * 2048 + k * 1024); } while (0)
#define PG8_LDB(dst, b, h) do { _Pragma("unroll") for (int n = 0; n < 2; ++n) _Pragma("unroll") for (int k = 0; k < 2; ++k) dst[n][k] = *(const PG8_LAS bf16x8*)(lds + PG8_SB(b, h) + boff + n * 2048 + k * 1024); } while (0)
#define PG8_MMA(ai, bj, At, Bt) do { __builtin_amdgcn_s_setprio(1); _Pragma("unroll") for (int m = 0; m < 4; ++m) _Pragma("unroll") for (int n = 0; n < 2; ++n) _Pragma("unroll") for (int k = 0; k < 2; ++k) \
        acc[ai][bj][m][n] = __builtin_amdgcn_mfma_f32_16x16x32_bf16(Bt[n][k], At[m][k], acc[ai][bj][m][n], 0, 0, 0); __builtin_amdgcn_s_setprio(0); } while (0)
#define PG8_WAIT_V(n) asm volatile("s_waitcnt vmcnt(" #n ")" ::: "memory")
#define PG8_WAIT_L(n) asm volatile("s_waitcnt lgkmcnt(" #n ")" ::: "memory")
#define PG8_BAR __builtin_amdgcn_s_barrier()
#define PG8_SCHED __builtin_amdgcn_sched_barrier(0)
    Unit cur, nxt; int ui = 0;
    if (!S.next(0, cur)) return;
    f32x4 acc[2][2][4][2];
#pragma unroll
    for (int a = 0; a < 2; ++a)
#pragma unroll
        for (int b = 0; b < 2; ++b)
#pragma unroll
            for (int m = 0; m < 4; ++m)
#pragma unroll
                for (int n = 0; n < 2; ++n) acc[a][b][m][n] = (f32x4){0.f, 0.f, 0.f, 0.f};
    bf16x8 At[4][2], B0[2][2], B1[2][2];
    const char* cA = (const char*)g.A + (size_t)cur.pm * tstep; const char* cB = (const char*)g.Bt + (size_t)cur.pn * tstep;
    S.a_ready(cur);
    if constexpr (SP2) {
        PG8_STAGE(PG8_SB(0, 0), cB, voffB); PG8_STAGE(PG8_SB(0, 1), cB + hstep, voffB); PG8_STAGE(PG8_SA(0, 0), cA, voffA); PG8_STAGE(PG8_SA(0, 1), cA + hstep, voffA);
        if (wr == 1) PG8_BAR;
        PG8_WAIT_V(2); PG8_BAR;
        PG8_STAGE(PG8_SB(1, 0), cB + kstep, voffB); PG8_STAGE(PG8_SA(1, 0), cA + kstep, voffA); PG8_STAGE(PG8_SB(1, 1), cB + hstep + kstep, voffB);
        PG8_WAIT_V(6); PG8_BAR;
    } else {
        PG8_STAGE(PG8_SB(0, 0), cB, voffB); PG8_STAGE(PG8_SA(0, 0), cA, voffA); PG8_STAGE(PG8_SB(0, 1), cB + hstep, voffB); PG8_STAGE(PG8_SA(0, 1), cA + hstep, voffA);
        if (wr == 1) PG8_BAR;
        PG8_WAIT_V(4); PG8_BAR;
        PG8_STAGE(PG8_SB(1, 0), cB + kstep, voffB); PG8_STAGE(PG8_SA(1, 0), cA + kstep, voffA); PG8_STAGE(PG8_SB(1, 1), cB + hstep + kstep, voffB);
        PG8_WAIT_V(6); PG8_BAR;
    }
    for (;;) {
        const bool has_next = S.next(ui + 1, nxt);
        const char* nA = has_next ? (const char*)g.A + (size_t)nxt.pm * tstep : cA; const char* nB = has_next ? (const char*)g.Bt + (size_t)nxt.pn * tstep : cB;
        for (int t = 0; t < nt; t += 2) {
            const bool last = (t == nt - 2);
            const char* a1 = cA + (size_t)(t + 1) * kstep;
            const char* a2 = last ? nA : cA + (size_t)(t + 2) * kstep; const char* b2 = last ? nB : cB + (size_t)(t + 2) * kstep;
            const char* a3 = a2 + kstep; const char* b3 = b2 + kstep;
            if (last && has_next) S.a_ready(nxt);
            if constexpr (SP2) {
            PG8_LDB(B0, 0, 0); PG8_LDB(B1, 0, 1); PG8_SCHED; PG8_LDA(At, 0, 0); PG8_STAGE(PG8_SA(1, 1), a1 + hstep, voffA);
            PG8_WAIT_V(8); PG8_WAIT_L(0); PG8_BAR; PG8_MMA(0, 0, At, B0); PG8_MMA(0, 1, At, B1); PG8_BAR; PG8_SCHED;
            PG8_LDA(At, 0, 1); PG8_STAGE(PG8_SB(0, 0), b2, voffB); PG8_STAGE(PG8_SB(0, 1), b2 + hstep, voffB); PG8_STAGE(PG8_SA(0, 0), a2, voffA);
            PG8_WAIT_V(8); PG8_WAIT_L(0); PG8_BAR; PG8_MMA(1, 0, At, B0); PG8_MMA(1, 1, At, B1); PG8_BAR; PG8_SCHED;
            PG8_LDB(B0, 1, 0); PG8_LDB(B1, 1, 1); PG8_SCHED; PG8_LDA(At, 1, 0); PG8_STAGE(PG8_SA(0, 1), a2 + hstep, voffA);
            PG8_WAIT_V(8); PG8_WAIT_L(0); PG8_BAR; PG8_MMA(0, 0, At, B0); PG8_MMA(0, 1, At, B1); PG8_BAR; PG8_SCHED;
            PG8_LDA(At, 1, 1); PG8_STAGE(PG8_SB(1, 0), b3, voffB); PG8_STAGE(PG8_SB(1, 1), b3 + hstep, voffB); PG8_STAGE(PG8_SA(1, 0), a3, voffA);
            PG8_WAIT_V(8); PG8_WAIT_L(0); PG8_BAR; PG8_MMA(1, 0, At, B0); PG8_MMA(1, 1, At, B1); PG8_BAR; PG8_SCHED;
            } else {
            PG8_LDB(B0, 0, 0); PG8_SCHED; PG8_LDA(At, 0, 0); PG8_STAGE(PG8_SA(1, 1), a1 + hstep, voffA);
            PG8_WAIT_L(8); PG8_BAR; PG8_WAIT_L(0); PG8_MMA(0, 0, At, B0); PG8_BAR; PG8_SCHED;
            PG8_LDB(B1, 0, 1); PG8_STAGE(PG8_SB(0, 0), b2, voffB);
            PG8_BAR; PG8_WAIT_L(0); PG8_MMA(0, 1, At, B1); PG8_BAR;
            PG8_LDA(At, 0, 1); PG8_STAGE(PG8_SA(0, 0), a2, voffA);
            PG8_BAR; PG8_WAIT_L(0); PG8_MMA(1, 0, At, B0); PG8_BAR; PG8_SCHED;
            PG8_STAGE(PG8_SB(0, 1), b2 + hstep, voffB);
            PG8_WAIT_V(6); PG8_BAR; PG8_MMA(1, 1, At, B1); PG8_BAR;
            PG8_LDB(B0, 1, 0); PG8_SCHED; PG8_LDA(At, 1, 0); PG8_STAGE(PG8_SA(0, 1), a2 + hstep, voffA);
            PG8_WAIT_L(8); PG8_BAR; PG8_WAIT_L(0); PG8_MMA(0, 0, At, B0); PG8_BAR; PG8_SCHED;
            PG8_LDB(B1, 1, 1); PG8_STAGE(PG8_SB(1, 0), b3, voffB);
            PG8_BAR; PG8_WAIT_L(0); PG8_MMA(0, 1, At, B1); PG8_BAR;
            PG8_LDA(At, 1, 1); PG8_STAGE(PG8_SA(1, 0), a3, voffA);
            PG8_BAR; PG8_WAIT_L(0); PG8_MMA(1, 0, At, B0); PG8_BAR; PG8_SCHED;
            PG8_STAGE(PG8_SB(1, 1), b3 + hstep, voffB);
            PG8_WAIT_V(6); PG8_BAR; PG8_MMA(1, 1, At, B1); PG8_BAR;
            }
        }
        if constexpr (ALIGN_EPI) { if (wr == 0) PG8_BAR; }
        if constexpr (!Epi::AFTER_DRAIN) { E(acc, cur, wr, wc, fr, fq); S.done(cur); }
        if (!has_next) break;
#pragma unroll
        for (int a = 0; a < 2; ++a)
#pragma unroll
            for (int b = 0; b < 2; ++b)
#pragma unroll
                for (int m = 0; m < 4; ++m)
#pragma unroll
                    for (int n = 0; n < 2; ++n) acc[a][b][m][n] = (f32x4){0.f, 0.f, 0.f, 0.f};
        cur = nxt; cA = nA; cB = nB; ++ui;
        if constexpr (ALIGN_EPI) { if (wr == 1) PG8_BAR; }
    }
    PG8_WAIT_V(0);
    if constexpr (!ALIGN_EPI) { if (wr == 0) PG8_BAR; }
    PG8_BAR;
    if constexpr (Epi::AFTER_DRAIN) { E.fused(acc, cur, wr, wc, fr, fq, lds, wid, lane); S.done(cur); }
#undef PG8_SA
#undef PG8_SB
#undef PG8_STAGE
#undef PG8_LDA
#undef PG8_LDB
#undef PG8_MMA
#undef PG8_WAIT_V
#undef PG8_WAIT_L
#undef PG8_BAR
#undef PG8_SCHED
}
}
#define GAS __attribute__((address_space(1)))
#define LAS __attribute__((address_space(3)))
typedef unsigned short bf16;
typedef unsigned v4u __attribute__((ext_vector_type(4)));
typedef float f32x4 __attribute__((ext_vector_type(4)));
typedef short bf16x8 __attribute__((ext_vector_type(8)));
typedef GAS unsigned gu32;
typedef GAS unsigned long long gu64;
#define RLX_AGENT __ATOMIC_RELAXED, __HIP_MEMORY_SCOPE_AGENT
#define LDS_WAIT() asm volatile("s_waitcnt lgkmcnt(0)" ::: "memory")
#define VM_WAIT() asm volatile("s_waitcnt vmcnt(0)" ::: "memory")
__device__ __forceinline__ unsigned long long rt() { return __builtin_amdgcn_s_memrealtime(); }
__device__ __forceinline__ unsigned f2bf(float f) { unsigned u = __builtin_bit_cast(unsigned, f); return (u + 0x7fffu + ((u >> 16) & 1u)) >> 16; }
__device__ __forceinline__ unsigned pk2(float lo, float hi) { return f2bf(lo) | (f2bf(hi) << 16); }

#define XB_TMO      128
#define XB_XCNT(j)  (256  + 64 * (j))
#define XB_XSUB(j)  (1280 + 64 * (j))
#define XB_XGEN(j)  (2304 + 64 * (j))
#define XB_TOP      3328
#define XB_TOPGEN   3392
#define XCD_BAR_WORDS 3456
#define XB_SPIN_CAP (1u << 18)

__device__ __forceinline__ unsigned xb_ld(unsigned* p)              { return __hip_atomic_load(p, __ATOMIC_RELAXED, __HIP_MEMORY_SCOPE_AGENT); }
__device__ __forceinline__ unsigned xb_add(unsigned* p, unsigned v) { return __hip_atomic_fetch_add(p, v, __ATOMIC_RELAXED, __HIP_MEMORY_SCOPE_AGENT); }
__device__ __forceinline__ unsigned xb_xcc_id() { return (unsigned)__builtin_amdgcn_s_getreg((3 << 11) | 20) & 0xFu; }
#define XB_SPIN(cond, bar) do { unsigned _sp = 0; while (cond) { __builtin_amdgcn_s_sleep(1); \
    if ((++_sp & 255u) == 0u) { if (xb_ld(&(bar)[XB_TMO])) break; if (_sp > XB_SPIN_CAP) { atomicAdd(&(bar)[XB_TMO], 1u); break; } } } } while (0)

struct XcdBarrier {
    unsigned* bar; unsigned x;
    volatile LAS unsigned* st;
};

__device__ __forceinline__ XcdBarrier xcd_barrier_post(unsigned* bar, volatile LAS unsigned* st) {
    XcdBarrier b; b.bar = bar; b.x = xb_xcc_id(); b.st = st;
    if (threadIdx.x == 0) (void)xb_add(&bar[XB_XCNT(b.x)], 1u);
    return b;
}
__device__ __forceinline__ void xcd_barrier_complete(unsigned* bar, unsigned x, unsigned& nloc, unsigned& nx) {
    const unsigned G = gridDim.x * gridDim.y * gridDim.z;
    unsigned sum, cnt, mine, sp = 0u;
    for (;;) {
        sum = 0u; cnt = 0u; mine = 0u;
#pragma unroll
        for (unsigned j = 0; j < 16; ++j) { const unsigned c = xb_ld(&bar[XB_XCNT(j)]); sum += c; cnt += (c > 0u) ? 1u : 0u; mine = (j == x) ? c : mine; }
        if (sum == G) break;
        __builtin_amdgcn_s_sleep(1);
        if ((++sp & 255u) == 0u) { if (xb_ld(&bar[XB_TMO])) break; if (sp > XB_SPIN_CAP) { atomicAdd(&bar[XB_TMO], 1u); break; } }
    }
    nloc = mine > 0u ? mine : 1u; nx = cnt > 0u ? cnt : 1u;
}

__device__ __forceinline__ void xcd_barrier(const XcdBarrier& b) {
    asm volatile("s_waitcnt vmcnt(0)" ::: "memory");
    __syncthreads();
    if (threadIdx.x == 0) {
        unsigned* bar = b.bar;
        __builtin_amdgcn_s_waitcnt(0);
        unsigned nloc = b.st[0], nx = b.st[1];
        if (nloc == 0u) { xcd_barrier_complete(bar, b.x, nloc, nx); b.st[0] = nloc; b.st[1] = nx; }
        const unsigned old = xb_add(&bar[XB_XSUB(b.x)], 1u);
        const unsigned gen = old / nloc;
        if (old + 1u == (gen + 1u) * nloc) {
            __builtin_amdgcn_fence(__ATOMIC_RELEASE, "agent");
            asm volatile("s_waitcnt vmcnt(0)" ::: "memory");
            const unsigned og = xb_add(&bar[XB_TOP], 1u);
            const unsigned tg = og / nx;
            if (og + 1u == (tg + 1u) * nx) xb_add(&bar[XB_TOPGEN], 1u);
            else XB_SPIN(xb_ld(&bar[XB_TOPGEN]) == tg, bar);
            __builtin_amdgcn_fence(__ATOMIC_ACQUIRE, "agent");
            xb_add(&bar[XB_XGEN(b.x)], 1u);
            asm volatile("s_waitcnt vmcnt(0)" ::: "memory");
        } else {
            XB_SPIN(xb_ld(&bar[XB_XGEN(b.x)]) == gen, bar);
            __builtin_amdgcn_fence(__ATOMIC_ACQUIRE, "agent");
            asm volatile("s_waitcnt vmcnt(0)" ::: "memory");
        }
    }
    __syncthreads();
}
constexpr int NWAVES = 8;
constexpr int D = 1024, MT = 16384, NCTX = 8192, NIN = 5664, DFF = 2816, N1P = 5888;
constexpr float EPSN = 1e-6f;
constexpr size_t MiB = 1u << 20;
constexpr size_t WS_CTL = 0, CTL_ZERO_BYTES = 1 * MiB;
constexpr size_t WS_WIN = 1 * MiB;
constexpr size_t WS_WFI = WS_WIN + (size_t)N1P * D * 2;
constexpr size_t WS_WFO = WS_WFI + (size_t)2 * DFF * D * 2;
constexpr size_t WS_WO = WS_WFO + (size_t)D * DFF * 2;
constexpr size_t WS_WBA = WS_WO + (size_t)D * D * 2;
constexpr size_t WS_WBB = WS_WBA + (size_t)D * 512 * 2;
static_assert(WS_WBB + (size_t)D * 512 * 2 == 33 * MiB, "weights fill [1,33) MiB");
constexpr size_t WS_H = 33 * MiB, WS_QKV = 65 * MiB, WS_Z = 113 * MiB, WS_CX = 129 * MiB, WS_BG = 145 * MiB, WS_GA = 161 * MiB, WS_GB = 193 * MiB, WS_BA = 225 * MiB, WS_OB = 227 * MiB;
constexpr size_t WS_OF = WS_H, WS_OBW = WS_H + 16 * MiB, WS_OA = WS_QKV, WS_M = WS_QKV + 16 * MiB, WS_MIX = WS_Z, WS_ACT = WS_Z, WS_Y = WS_H, WS_END = 256 * MiB;
constexpr int CW_BAR = 4096;
constexpr int CW_MOD = 131072;
constexpr int RING_OFF = 0, RING_BYTES = 131072, LDSCTL_OFF = RING_BYTES, MISC_OFF = LDSCTL_OFF + 320, LDS_BYTES = 147456;

__device__ __forceinline__ float wave_sum(float v) {
#pragma unroll
    for (int o = 1; o < 64; o <<= 1) v += __shfl_xor(v, o);
    return v;
}
__device__ __forceinline__ float bf2f(unsigned short b) { return __uint_as_float(((unsigned)b) << 16); }
__device__ __forceinline__ float bflo(unsigned w) { return __uint_as_float(w << 16); }
__device__ __forceinline__ float bfhi(unsigned w) { return __uint_as_float(w & 0xffff0000u); }
__device__ __forceinline__ float siluf(float x) { return x / (1.f + __expf(-x)); }
__device__ __forceinline__ float sigmf(float x) { return 1.f / (1.f + __expf(-x)); }
__device__ __forceinline__ float softplusf(float x) { return x > 20.f ? x : log1pf(__expf(x)); }
__device__ __forceinline__ int lane_id_fresh() { int l; asm volatile("v_mbcnt_lo_u32_b32 %0, -1, 0\n\tv_mbcnt_hi_u32_b32 %0, -1, %0" : "=v"(l)); return l; }
__device__ __forceinline__ float rdl(float v, int l) { return __int_as_float(__builtin_amdgcn_readlane(__float_as_int(v), l)); }
__device__ __forceinline__ int mod_index(int r) { return r < NCTX ? 0 : 1 + (r - NCTX) / 2048; }

namespace pg8 {
__device__ __forceinline__ u32x4 pack8(const f32x4& v0, const f32x4& v1) { u32x4 w; w.x = cvt_pk_bf16(v0[0], v0[1]); w.y = cvt_pk_bf16(v0[2], v0[3]); w.z = cvt_pk_bf16(v1[0], v1[1]); w.w = cvt_pk_bf16(v1[2], v1[3]); return w; }
__device__ __forceinline__ f32x4 silu4(f32x4 v) { f32x4 o; for (int j = 0; j < 4; ++j) o[j] = v[j] / (1.f + __expf(-v[j])); return o; }
__device__ __forceinline__ f32x4 sigm4(f32x4 v) { f32x4 o; for (int j = 0; j < 4; ++j) o[j] = 1.f / (1.f + __expf(-v[j])); return o; }

struct EpiG1 {
    static constexpr bool PERM = true, AFTER_DRAIN = false;
    bf16_t *QKV, *Z, *CX, *BG, *GA, *GB; float* BA;
    __device__ __forceinline__ void operator()(const f32x4 (&acc)[2][2][4][2], const Unit& u, int wr, int wc, int fr_, int fq_) const {
        int fr = fr_, fq = fq_; asm volatile("" : "+v"(fr), "+v"(fq));
        const int row0 = u.pm * BM + wr * 64 + fr, c8 = wc * 32 + 8 * fq, pn = u.pn;
        if (pn == 22) {
            if (wc == 0) {
#pragma unroll
                for (int ai = 0; ai < 2; ++ai)
#pragma unroll
                    for (int m = 0; m < 4; ++m) { float* p = BA + (size_t)(row0 + ai * HALF + m * 16) * 32 + 8 * fq; *(f32x4*)p = acc[ai][0][m][0]; *(f32x4*)(p + 4) = acc[ai][0][m][1]; }
            }
            return;
        }
        if (pn >= 8 && pn < 12) {
#pragma unroll
            for (int ai = 0; ai < 2; ++ai)
#pragma unroll
                for (int m = 0; m < 4; ++m) { bf16_t* p = CX + (size_t)(row0 + ai * HALF + m * 16) * 512 + 128 * (pn - 8) + c8; *(u32x4*)p = pack8(acc[ai][0][m][0] * acc[ai][1][m][0], acc[ai][0][m][1] * acc[ai][1][m][1]); }
            return;
        }
        bf16_t* base; int ld, col0, mode;
        if (pn < 6) { base = QKV; ld = 1536; col0 = 256 * pn; mode = 0; }
        else if (pn < 8) { base = Z; ld = 512; col0 = 256 * (pn - 6); mode = 1; }
        else if (pn < 14) { base = BG; ld = 512; col0 = 256 * (pn - 12); mode = 0; }
        else if (pn < 18) { base = GA; ld = 1024; col0 = 256 * (pn - 14); mode = 2; }
        else { base = GB; ld = 1024; col0 = 256 * (pn - 18); mode = 2; }
#pragma unroll
        for (int ai = 0; ai < 2; ++ai)
#pragma unroll
            for (int m = 0; m < 4; ++m) { bf16_t* rowp = base + (size_t)(row0 + ai * HALF + m * 16) * ld + col0 + c8;
#pragma unroll
                for (int bj = 0; bj < 2; ++bj) { f32x4 v0 = acc[ai][bj][m][0], v1 = acc[ai][bj][m][1];
                    if (mode == 1) { v0 = silu4(v0); v1 = silu4(v1); }
                    if (mode == 2) { v0 = sigm4(v0); v1 = sigm4(v1); }
                    *(u32x4*)(rowp + bj * HALF) = pack8(v0, v1); } }
    }
};
struct EpiFfnIn {
    static constexpr bool PERM = true, AFTER_DRAIN = false;
    bf16_t* ACT;
    __device__ __forceinline__ void operator()(const f32x4 (&acc)[2][2][4][2], const Unit& u, int wr, int wc, int fr_, int fq_) const {
        int fr = fr_, fq = fq_; asm volatile("" : "+v"(fr), "+v"(fq));
        const int row0 = u.pm * BM + wr * 64 + fr, c8 = wc * 32 + 8 * fq;
#pragma unroll
        for (int ai = 0; ai < 2; ++ai)
#pragma unroll
            for (int m = 0; m < 4; ++m) { bf16_t* p = ACT + (size_t)(row0 + ai * HALF + m * 16) * DFF + 128 * u.pn + c8;
                *(u32x4*)p = pack8(silu4(acc[ai][0][m][0]) * acc[ai][1][m][0], silu4(acc[ai][0][m][1]) * acc[ai][1][m][1]); }
    }
};
template <int PASS> struct EpiBr {
    static constexpr bool PERM = true, AFTER_DRAIN = false;
    bf16_t* Mb; const bf16_t* G;
    __device__ __forceinline__ void operator()(const f32x4 (&acc)[2][2][4][2], const Unit& u, int wr, int wc, int fr_, int fq_) const {
        int fr = fr_, fq = fq_; asm volatile("" : "+v"(fr), "+v"(fq));
        const int row0 = u.pm * BM + wr * 64 + fr, c8 = u.pn * BM + wc * 32 + 8 * fq;
#pragma unroll
        for (int ai = 0; ai < 2; ++ai)
#pragma unroll
            for (int m = 0; m < 4; ++m)
#pragma unroll
                for (int bj = 0; bj < 2; ++bj) { const size_t off = (size_t)(row0 + ai * HALF + m * 16) * D + c8 + bj * HALF;
                    const u32x4 g = *(const u32x4*)(G + off); f32x4 v0 = acc[ai][bj][m][0], v1 = acc[ai][bj][m][1];
                    v0[0] *= bflo(g.x); v0[1] *= bfhi(g.x); v0[2] *= bflo(g.y); v0[3] *= bfhi(g.y); v1[0] *= bflo(g.z); v1[1] *= bfhi(g.z); v1[2] *= bflo(g.w); v1[3] *= bfhi(g.w);
                    if (PASS == 1) { const u32x4 o = *(const u32x4*)(Mb + off); v0[0] += bflo(o.x); v0[1] += bfhi(o.x); v0[2] += bflo(o.y); v0[3] += bfhi(o.y); v1[0] += bflo(o.z); v1[1] += bfhi(o.z); v1[2] += bflo(o.w); v1[3] += bfhi(o.w); }
                    *(u32x4*)(Mb + off) = pack8(v0, v1); }
    }
};
struct EpiF32 {
    static constexpr bool PERM = false, AFTER_DRAIN = false;
    float* C; int ldc;
    __device__ __forceinline__ void operator()(const f32x4 (&acc)[2][2][4][2], const Unit& u, int wr, int wc, int fr_, int fq_) const {
        int fr = fr_, fq = fq_; asm volatile("" : "+v"(fr), "+v"(fq));
        const int row0 = u.pm * BM + wr * 64 + fr, col0 = u.pn * BM + wc * 32 + 4 * fq;
#pragma unroll
        for (int ai = 0; ai < 2; ++ai)
#pragma unroll
            for (int m = 0; m < 4; ++m) { float* rowp = C + (size_t)(row0 + ai * HALF + m * 16) * ldc + col0;
#pragma unroll
                for (int bj = 0; bj < 2; ++bj)
#pragma unroll
                    for (int n = 0; n < 2; ++n) *(f32x4*)(rowp + bj * HALF + n * 16) = acc[ai][bj][m][n]; }
    }
};
}

struct Frame {
    LAS unsigned char* lds; volatile LAS unsigned* MISC; gu32* ctl;
    int tid, lane, wave, vcu, G;
    const float *x_prompt, *x_sample, *state_delta, *c, *c_ctx, *w_mod, *b_mod, *gains, *w_in, *conv_qkv, *a_log, *dt_bias, *onorm, *conv_sc, *w_bra, *w_brb, *w_out, *w_ffn_in, *w_ffn_out;
    float* out; unsigned char* ws;
};
__device__ __forceinline__ const float* xrow(const Frame& F, int r) { return r < NCTX ? F.x_prompt + (size_t)r * D : F.x_sample + (size_t)(r - NCTX) * D; }

__device__ __forceinline__ void transpose_item(const float* W, int K, int N, bf16* WT, int src_col0, int dst_row0, int k0, LAS float* scr, int lane) {
#pragma unroll 8
    for (int i = 0; i < 32; ++i) { const int kk = 2 * i + (lane >> 5); scr[kk * 33 + (lane & 31)] = W[(size_t)(k0 + kk) * N + src_col0 + (lane & 31)]; }
    LDS_WAIT(); asm volatile("" ::: "memory");
    const int c = lane & 7;
#pragma unroll
    for (int j = 0; j < 4; ++j) { const int n = (lane >> 3) + 8 * j; const LAS float* s = scr + (8 * c) * 33 + n;
        v4u o; o.x = pk2(s[0 * 33], s[1 * 33]); o.y = pk2(s[2 * 33], s[3 * 33]); o.z = pk2(s[4 * 33], s[5 * 33]); o.w = pk2(s[6 * 33], s[7 * 33]);
        *(GAS v4u*)(WT + (size_t)(dst_row0 + n) * K + k0 + 8 * c) = o; }
    LDS_WAIT(); asm volatile("" ::: "memory");
}
__device__ __forceinline__ void zero_item(bf16* WT, int K, int dst_row0, int k0, int lane) {
    const int c = lane & 7;
#pragma unroll
    for (int j = 0; j < 4; ++j) { const int n = (lane >> 3) + 8 * j; *(GAS v4u*)(WT + (size_t)(dst_row0 + n) * K + k0 + 8 * c) = (v4u){0u, 0u, 0u, 0u}; }
}
__device__ __forceinline__ int win_src(int d0) {
    if (d0 < 2048) return d0;
    if (d0 < 3072) { const int t = d0 - 2048, i = t >> 8, w = t & 255; return w < 128 ? 2592 + 128 * i + w : 3104 + 128 * i + (w - 128); }
    if (d0 < 3584) return 2080 + (d0 - 3072);
    if (d0 < 4608) return 3616 + (d0 - 3584);
    if (d0 < 5632) return 4640 + (d0 - 4608);
    if (d0 == 5632) return 2048;
    return -1;
}
__device__ __forceinline__ void p0_prologue(Frame& F) {
    LAS float* scr = (LAS float*)(F.lds + RING_OFF + F.wave * 16384);
    const int gw = F.vcu * NWAVES + F.wave, NGW = F.G * NWAVES;
    bf16* WIN = (bf16*)(F.ws + WS_WIN); bf16* WFI = (bf16*)(F.ws + WS_WFI); bf16* WFO = (bf16*)(F.ws + WS_WFO); bf16* WO = (bf16*)(F.ws + WS_WO); bf16* WBA = (bf16*)(F.ws + WS_WBA); bf16* WBB = (bf16*)(F.ws + WS_WBB);
    constexpr int I_IN = (N1P / 32) * 16, I_FI = (2 * DFF / 32) * 16, I_FO = (D / 32) * (DFF / 64), I_O = (D / 32) * 16, I_B = (D / 32) * 8;
    constexpr int NITEMS = I_IN + I_FI + I_FO + I_O + 2 * I_B;
    for (int it = gw; it < NITEMS; it += NGW) {
        int r = it;
        if (r < I_IN) { const int nb = r >> 4, kb = r & 15, src = win_src(32 * nb); if (src >= 0) transpose_item(F.w_in, D, NIN, WIN, src, 32 * nb, 64 * kb, scr, F.lane); else zero_item(WIN, D, 32 * nb, 64 * kb, F.lane); continue; } r -= I_IN;
        if (r < I_FI) { const int nb = r >> 4, kb = r & 15, d0 = 32 * nb, i = d0 >> 8, w = d0 & 255, src = w < 128 ? 128 * i + w : DFF + 128 * i + (w - 128); transpose_item(F.w_ffn_in, D, 2 * DFF, WFI, src, d0, 64 * kb, scr, F.lane); continue; } r -= I_FI;
        if (r < I_FO) { const int nb = r / (DFF / 64), kb = r % (DFF / 64); transpose_item(F.w_ffn_out, DFF, D, WFO, 32 * nb, 32 * nb, 64 * kb, scr, F.lane); continue; } r -= I_FO;
        if (r < I_O) { const int nb = r >> 4, kb = r & 15; transpose_item(F.w_out, D, D, WO, 32 * nb, 32 * nb, 64 * kb, scr, F.lane); continue; } r -= I_O;
        if (r < I_B) { const int nb = r >> 3, kb = r & 7; transpose_item(F.w_bra, 512, D, WBA, 32 * nb, 32 * nb, 64 * kb, scr, F.lane); continue; } r -= I_B;
        { const int nb = r >> 3, kb = r & 7; transpose_item(F.w_brb, 512, D, WBB, 32 * nb, 32 * nb, 64 * kb, scr, F.lane); }
    }
    float* mod = (float*)(F.ctl + CW_MOD);
    for (int it = gw; it < 24 * 32; it += NGW) {
        const int cg = it % 24, ks = it / 24, col = 256 * cg + 4 * F.lane;
        f32x4 acc[5];
#pragma unroll
        for (int r = 0; r < 5; ++r) acc[r] = (f32x4){0.f, 0.f, 0.f, 0.f};
#pragma unroll 8
        for (int kk = 0; kk < 32; ++kk) { const int k = 32 * ks + kk; const f32x4 w = *(const GAS f32x4*)(F.w_mod + (size_t)k * 6144 + col);
            acc[0] += siluf(F.c_ctx[k]) * w;
#pragma unroll
            for (int b = 0; b < 4; ++b) acc[1 + b] += siluf(F.c[b * D + k]) * w; }
        if (ks == 0) { const f32x4 bm = *(const GAS f32x4*)(F.b_mod + col);
#pragma unroll
            for (int r = 0; r < 5; ++r) acc[r] += bm; }
#pragma unroll
        for (int r = 0; r < 5; ++r)
#pragma unroll
            for (int e = 0; e < 4; ++e) atomicAdd(mod + r * 6144 + col + e, acc[r][e]);
    }
}
__device__ __forceinline__ void p1_norm_rows(Frame& F) {
    const int gw = F.vcu * NWAVES + F.wave, NGW = F.G * NWAVES;
    const float* mod = (const float*)(F.ctl + CW_MOD); bf16* H = (bf16*)(F.ws + WS_H);
    for (int r = gw; r < MT; r += NGW) {
        const GAS f32x4* xr = (const GAS f32x4*)xrow(F, r) + F.lane; const float* m = mod + mod_index(r) * 6144;
        f32x4 v[4]; float s = 0.f;
#pragma unroll
        for (int j = 0; j < 4; ++j) { v[j] = xr[64 * j]; s += (v[j].x * v[j].x + v[j].y * v[j].y) + (v[j].z * v[j].z + v[j].w * v[j].w); }
        const float rstd = rsqrtf(wave_sum(s) * (1.f / D) + EPSN);
        GAS unsigned long long* o8 = (GAS unsigned long long*)(H + (size_t)r * D) + F.lane;
#pragma unroll
        for (int j = 0; j < 4; ++j) { const int k = 4 * F.lane + 256 * j; const f32x4 g = *(const GAS f32x4*)(F.gains + k), sc = *(const f32x4*)(m + 1024 + k), sh = *(const f32x4*)(m + k);
            const f32x4 h = v[j] * rstd * g * (sc + 1.f) + sh;
            o8[64 * j] = (unsigned long long)pk2(h.x, h.y) | ((unsigned long long)pk2(h.z, h.w) << 32); }
    }
}
__device__ __forceinline__ void delta_naive_item(Frame& F, int item) {
    const int lane = F.lane;
    const int dir = item & 1, s = item >> 1;
    const bool ctx = s >= 32; const int sl = ctx ? s - 32 : s, b = sl >> 3, h = sl & 7;
    const int T = ctx ? 256 : 2048, row0 = ctx ? b * 256 : NCTX + b * 2048, seglen = ctx ? 256 : 64;
    const bf16* QKV = (const bf16*)(F.ws + WS_QKV); const float* BA = (const float*)(F.ws + WS_BA);
    bf16* O = (bf16*)(F.ws + (dir ? WS_OBW : WS_OF));
    float S[64];
#pragma unroll
    for (int dk = 0; dk < 64; ++dk) S[dk] = ctx ? 0.f : F.state_delta[((size_t)(b * 2 + dir) * 8 + h) * 4096 + dk * 64 + lane];
    const float Aexp = __expf(F.a_log[dir * 8 + h]), dtb = F.dt_bias[dir * 8 + h];
    float wq[3], wk[3], wv[3];
#pragma unroll
    for (int j = 0; j < 3; ++j) { wq[j] = F.conv_qkv[j * 1536 + h * 64 + lane]; wk[j] = F.conv_qkv[j * 1536 + 512 + h * 64 + lane]; wv[j] = F.conv_qkv[j * 1536 + 1024 + h * 64 + lane]; }
    for (int step = 0; step < T; ++step) {
        const int t = dir ? T - 1 - step : step, r = row0 + t, pos = t % seglen;
        float q = 0.f, k = 0.f, v = 0.f;
#pragma unroll
        for (int j = 0; j < 3; ++j) { const int pp = pos + j - 1;
            if (pp >= 0 && pp < seglen) { const bf16* p = QKV + (size_t)(r + j - 1) * 1536 + h * 64 + lane; q += wq[j] * bf2f(p[0]); k += wk[j] * bf2f(p[512]); v += wv[j] * bf2f(p[1024]); } }
        q = siluf(q); k = siluf(k); v = siluf(v);
        q = q * rsqrtf(wave_sum(q * q) + EPSN) * 0.125f;
        k = k * rsqrtf(wave_sum(k * k) + EPSN);
        const float beta = sigmf(BA[(size_t)r * 32 + dir * 8 + h]);
        const float g = -Aexp * softplusf(BA[(size_t)r * 32 + 16 + dir * 8 + h] + dtb);
        const float a = __expf(g);
        float kS = 0.f;
#pragma unroll
        for (int dk = 0; dk < 64; ++dk) kS += rdl(k, dk) * S[dk];
        const float cc = beta * (v - a * kS);
        float o = 0.f;
#pragma unroll
        for (int dk = 0; dk < 64; ++dk) { S[dk] = a * S[dk] + rdl(k, dk) * cc; o += rdl(q, dk) * S[dk]; }
        O[(size_t)r * 512 + h * 64 + lane] = (bf16)f2bf(o);
    }
    if (ctx) { float* os = F.out + (size_t)MT * D;
#pragma unroll
        for (int dk = 0; dk < 64; ++dk) os[((size_t)(b * 2 + dir) * 8 + h) * 4096 + dk * 64 + lane] = S[dk]; }
}
__device__ __forceinline__ void ob_phase(Frame& F) {
    const bf16* CX = (const bf16*)(F.ws + WS_CX); const bf16* BG = (const bf16*)(F.ws + WS_BG); bf16* OB = (bf16*)(F.ws + WS_OB);
    const int gt = (F.vcu * NWAVES + F.wave) * 64 + F.lane, NGT = F.G * NWAVES * 64;
    for (int idx = gt; idx < MT * 64; idx += NGT) {
        const int r = idx >> 6, j0 = (idx & 63) * 8; const int seglen = r < NCTX ? 256 : 64, pos = r % seglen;
        float acc[8];
#pragma unroll
        for (int e = 0; e < 8; ++e) acc[e] = 0.f;
#pragma unroll
        for (int tp = 0; tp < 3; ++tp) { const int pp = pos + tp - 1;
            if (pp >= 0 && pp < seglen) { const v4u cv = *(const GAS v4u*)(CX + (size_t)(r + tp - 1) * 512 + j0); const f32x4 w0 = *(const GAS f32x4*)(F.conv_sc + tp * 512 + j0), w1 = *(const GAS f32x4*)(F.conv_sc + tp * 512 + j0 + 4);
                acc[0] += w0.x * bflo(cv.x); acc[1] += w0.y * bfhi(cv.x); acc[2] += w0.z * bflo(cv.y); acc[3] += w0.w * bfhi(cv.y); acc[4] += w1.x * bflo(cv.z); acc[5] += w1.y * bfhi(cv.z); acc[6] += w1.z * bflo(cv.w); acc[7] += w1.w * bfhi(cv.w); } }
        const v4u bg = *(const GAS v4u*)(BG + (size_t)r * 512 + j0);
        v4u o; o.x = pk2(acc[0] * bflo(bg.x), acc[1] * bfhi(bg.x)); o.y = pk2(acc[2] * bflo(bg.y), acc[3] * bfhi(bg.y)); o.z = pk2(acc[4] * bflo(bg.z), acc[5] * bfhi(bg.z)); o.w = pk2(acc[6] * bflo(bg.w), acc[7] * bfhi(bg.w));
        *(GAS v4u*)(OB + (size_t)r * 512 + j0) = o;
    }
}
__device__ __forceinline__ void oa_phase(Frame& F) {
    const bf16* OF = (const bf16*)(F.ws + WS_OF); const bf16* OBW = (const bf16*)(F.ws + WS_OBW); const bf16* Z = (const bf16*)(F.ws + WS_Z); bf16* OA = (bf16*)(F.ws + WS_OA);
    const int gw = F.vcu * NWAVES + F.wave, NGW = F.G * NWAVES; const int j0 = 8 * F.lane, d0 = j0 & 63;
    const f32x4 on0 = *(const GAS f32x4*)(F.onorm + d0), on1 = *(const GAS f32x4*)(F.onorm + d0 + 4);
    for (int r = gw; r < MT; r += NGW) {
        const v4u a = *(const GAS v4u*)(OF + (size_t)r * 512 + j0), b = *(const GAS v4u*)(OBW + (size_t)r * 512 + j0), z = *(const GAS v4u*)(Z + (size_t)r * 512 + j0);
        float o[8] = {bflo(a.x) + bflo(b.x), bfhi(a.x) + bfhi(b.x), bflo(a.y) + bflo(b.y), bfhi(a.y) + bfhi(b.y), bflo(a.z) + bflo(b.z), bfhi(a.z) + bfhi(b.z), bflo(a.w) + bflo(b.w), bfhi(a.w) + bfhi(b.w)};
        float s = 0.f;
#pragma unroll
        for (int e = 0; e < 8; ++e) s += o[e] * o[e];
        s += __shfl_xor(s, 1); s += __shfl_xor(s, 2); s += __shfl_xor(s, 4);
        const float rs = rsqrtf(s * (1.f / 64.f) + EPSN);
        v4u w; w.x = pk2(o[0] * rs * on0.x * bflo(z.x), o[1] * rs * on0.y * bfhi(z.x)); w.y = pk2(o[2] * rs * on0.z * bflo(z.y), o[3] * rs * on0.w * bfhi(z.y));
        w.z = pk2(o[4] * rs * on1.x * bflo(z.z), o[5] * rs * on1.y * bfhi(z.z)); w.w = pk2(o[6] * rs * on1.z * bflo(z.w), o[7] * rs * on1.w * bfhi(z.w));
        *(GAS v4u*)(OA + (size_t)r * 512 + j0) = w;
    }
}
__device__ __forceinline__ void resnorm_phase(Frame& F) {
    const int gw = F.vcu * NWAVES + F.wave, NGW = F.G * NWAVES;
    const float* mod = (const float*)(F.ctl + CW_MOD); const float* MIX = (const float*)(F.ws + WS_MIX); bf16* H = (bf16*)(F.ws + WS_H);
    for (int r = gw; r < MT; r += NGW) {
        const GAS f32x4* xr = (const GAS f32x4*)xrow(F, r) + F.lane; const GAS f32x4* mr = (const GAS f32x4*)(MIX + (size_t)r * D) + F.lane; const float* m = mod + mod_index(r) * 6144;
        f32x4 v[4]; float s = 0.f;
#pragma unroll
        for (int j = 0; j < 4; ++j) { v[j] = mr[64 * j]; s += (v[j].x * v[j].x + v[j].y * v[j].y) + (v[j].z * v[j].z + v[j].w * v[j].w); }
        const float rstd = rsqrtf(wave_sum(s) * (1.f / D) + EPSN); float s2 = 0.f;
        GAS f32x4* orow = (GAS f32x4*)(F.out + (size_t)r * D) + F.lane;
#pragma unroll
        for (int j = 0; j < 4; ++j) { const int k = 4 * F.lane + 256 * j; const f32x4 g = *(const GAS f32x4*)(F.gains + 1024 + k), gt = *(const f32x4*)(m + 2048 + k);
            v[j] = xr[64 * j] + gt * (v[j] * rstd * g); s2 += (v[j].x * v[j].x + v[j].y * v[j].y) + (v[j].z * v[j].z + v[j].w * v[j].w); orow[64 * j] = v[j]; }
        const float rstd2 = rsqrtf(wave_sum(s2) * (1.f / D) + EPSN);
        GAS unsigned long long* o8 = (GAS unsigned long long*)(H + (size_t)r * D) + F.lane;
#pragma unroll
        for (int j = 0; j < 4; ++j) { const int k = 4 * F.lane + 256 * j; const f32x4 g = *(const GAS f32x4*)(F.gains + 2048 + k), sc = *(const f32x4*)(m + 4096 + k), sh = *(const f32x4*)(m + 3072 + k);
            const f32x4 h = v[j] * rstd2 * g * (sc + 1.f) + sh;
            o8[64 * j] = (unsigned long long)pk2(h.x, h.y) | ((unsigned long long)pk2(h.z, h.w) << 32); }
    }
}
__device__ __forceinline__ void final_phase(Frame& F) {
    const int gw = F.vcu * NWAVES + F.wave, NGW = F.G * NWAVES;
    const float* mod = (const float*)(F.ctl + CW_MOD); const float* Y = (const float*)(F.ws + WS_Y);
    for (int r = gw; r < MT; r += NGW) {
        const GAS f32x4* yr = (const GAS f32x4*)(Y + (size_t)r * D) + F.lane; const float* m = mod + mod_index(r) * 6144;
        f32x4 v[4]; float s = 0.f;
#pragma unroll
        for (int j = 0; j < 4; ++j) { v[j] = yr[64 * j]; s += (v[j].x * v[j].x + v[j].y * v[j].y) + (v[j].z * v[j].z + v[j].w * v[j].w); }
        const float rstd = rsqrtf(wave_sum(s) * (1.f / D) + EPSN);
        GAS f32x4* orow = (GAS f32x4*)(F.out + (size_t)r * D) + F.lane;
#pragma unroll
        for (int j = 0; j < 4; ++j) { const int k = 4 * F.lane + 256 * j; const f32x4 g = *(const GAS f32x4*)(F.gains + 3072 + k), gt = *(const f32x4*)(m + 5120 + k);
            orow[64 * j] = orow[64 * j] + gt * (v[j] * rstd * g); }
    }
}

struct Args { const float* in[19]; float* out; unsigned char* ws; };
__global__ void __launch_bounds__(NWAVES * 64, 2) mega_fwd(Args args) {
    extern __shared__ __attribute__((aligned(16))) unsigned char lds[];
    Frame F;
    F.lds = (LAS unsigned char*)lds; F.MISC = (volatile LAS unsigned*)(F.lds + MISC_OFF);
    F.wave = __builtin_amdgcn_readfirstlane((int)threadIdx.x >> 6); F.lane = lane_id_fresh(); F.tid = F.wave * 64 + F.lane;
    F.G = gridDim.x; { const int bx = blockIdx.x; F.vcu = (F.G % 8 == 0) ? (bx % 8) * (F.G / 8) + bx / 8 : bx; }
    F.ws = args.ws; F.out = args.out; F.ctl = (gu32*)(args.ws + WS_CTL);
    F.x_prompt = args.in[0]; F.x_sample = args.in[1]; F.state_delta = args.in[2]; F.c = args.in[3]; F.c_ctx = args.in[4]; F.w_mod = args.in[5]; F.b_mod = args.in[6]; F.gains = args.in[7];
    F.w_in = args.in[8]; F.conv_qkv = args.in[9]; F.a_log = args.in[10]; F.dt_bias = args.in[11]; F.onorm = args.in[12]; F.conv_sc = args.in[13]; F.w_bra = args.in[14]; F.w_brb = args.in[15];
    F.w_out = args.in[16]; F.w_ffn_in = args.in[17]; F.w_ffn_out = args.in[18];
    for (int u = F.tid; u < (LDS_BYTES - LDSCTL_OFF) / 4; u += NWAVES * 64) ((LAS unsigned*)(F.lds + LDSCTL_OFF))[u] = 0u;
    __syncthreads();
    XcdBarrier bar = xcd_barrier_post((unsigned*)(F.ctl + CW_BAR), F.MISC + 8);
#define GRID_BAR() do { xcd_barrier(bar); F.lane = lane_id_fresh(); F.tid = F.wave * 64 + F.lane; } while (0)
    typedef pg8::bf16_t pb;
    p0_prologue(F); GRID_BAR();
    p1_norm_rows(F); GRID_BAR();
    { pg8::Gemm g{(const pb*)(F.ws + WS_H), (const pb*)(F.ws + WS_WIN), MT, N1P, D}; pg8::StaticOrder S; S.init(MT, N1P, F.G, (int)blockIdx.x);
      pg8::EpiG1 E{(pb*)(F.ws + WS_QKV), (pb*)(F.ws + WS_Z), (pb*)(F.ws + WS_CX), (pb*)(F.ws + WS_BG), (pb*)(F.ws + WS_GA), (pb*)(F.ws + WS_GB), (float*)(F.ws + WS_BA)};
      pg8::gemm_phase<pg8::EpiG1, pg8::StaticOrder, true, true>(F.lds + RING_OFF, g, S, E, F.wave); }
    GRID_BAR();
    { const int gw = F.vcu * NWAVES + F.wave; if (gw < 576) delta_naive_item(F, gw); ob_phase(F); }
    GRID_BAR();
    oa_phase(F); GRID_BAR();
    { pg8::Gemm g{(const pb*)(F.ws + WS_OA), (const pb*)(F.ws + WS_WBA), MT, D, 512}; pg8::StaticOrder S; S.init(MT, D, F.G, (int)blockIdx.x);
      pg8::EpiBr<0> E{(pb*)(F.ws + WS_M), (const pb*)(F.ws + WS_GA)};
      pg8::gemm_phase<pg8::EpiBr<0>, pg8::StaticOrder, true, true>(F.lds + RING_OFF, g, S, E, F.wave); }
    { pg8::Gemm g{(const pb*)(F.ws + WS_OB), (const pb*)(F.ws + WS_WBB), MT, D, 512}; pg8::StaticOrder S; S.init(MT, D, F.G, (int)blockIdx.x);
      pg8::EpiBr<1> E{(pb*)(F.ws + WS_M), (const pb*)(F.ws + WS_GB)};
      pg8::gemm_phase<pg8::EpiBr<1>, pg8::StaticOrder, true, true>(F.lds + RING_OFF, g, S, E, F.wave); }
    GRID_BAR();
    { pg8::Gemm g{(const pb*)(F.ws + WS_M), (const pb*)(F.ws + WS_WO), MT, D, D}; pg8::StaticOrder S; S.init(MT, D, F.G, (int)blockIdx.x);
      pg8::EpiF32 E{(float*)(F.ws + WS_MIX), D};
      pg8::gemm_phase<pg8::EpiF32, pg8::StaticOrder, true, true>(F.lds + RING_OFF, g, S, E, F.wave); }
    GRID_BAR();
    resnorm_phase(F); GRID_BAR();
    { pg8::Gemm g{(const pb*)(F.ws + WS_H), (const pb*)(F.ws + WS_WFI), MT, 2 * DFF, D}; pg8::StaticOrder S; S.init(MT, 2 * DFF, F.G, (int)blockIdx.x);
      pg8::EpiFfnIn E{(pb*)(F.ws + WS_ACT)};
      pg8::gemm_phase<pg8::EpiFfnIn, pg8::StaticOrder, true, true>(F.lds + RING_OFF, g, S, E, F.wave); }
    GRID_BAR();
    { pg8::Gemm g{(const pb*)(F.ws + WS_ACT), (const pb*)(F.ws + WS_WFO), MT, D, DFF}; pg8::StaticOrder S; S.init(MT, D, F.G, (int)blockIdx.x);
      pg8::EpiF32 E{(float*)(F.ws + WS_Y), D};
      pg8::gemm_phase<pg8::EpiF32, pg8::StaticOrder, true, true>(F.lds + RING_OFF, g, S, E, F.wave); }
    GRID_BAR();
    final_phase(F);
}

extern "C" void kernel_launch(void* const* d_in, const int* in_sizes, int n_in, void* d_out, int out_size, void* d_ws, size_t ws_size, hipStream_t stream) {
    static int grid = 0;
    if (grid == 0) {
        if (n_in != 19 || ws_size < WS_END) { fprintf(stderr, "kernel_launch: expected 19 inputs and >= %zu bytes of workspace; got %d, %zu\n", (size_t)WS_END, n_in, ws_size); grid = -1; return; }
        int dev = 0, cus = 0, per_cu = 0;
        if (hipGetDevice(&dev) != hipSuccess || hipDeviceGetAttribute(&cus, hipDeviceAttributeMultiprocessorCount, dev) != hipSuccess) { grid = -1; return; }
        if (hipFuncSetAttribute((const void*)mega_fwd, hipFuncAttributeMaxDynamicSharedMemorySize, LDS_BYTES) != hipSuccess) { fprintf(stderr, "kernel_launch: hipFuncSetAttribute failed\n"); grid = -1; return; }
        if (hipOccupancyMaxActiveBlocksPerMultiprocessor(&per_cu, (const void*)mega_fwd, NWAVES * 64, LDS_BYTES) != hipSuccess || per_cu < 1) fprintf(stderr, "kernel_launch: occupancy query reports %d blocks/CU\n", per_cu);
        (void)hipGetLastError();
        grid = cus;
    }
    if (grid < 0) return;
    if (hipMemsetAsync((char*)d_ws + WS_CTL, 0, CTL_ZERO_BYTES, stream) != hipSuccess) { fprintf(stderr, "kernel_launch: memset failed\n"); return; }
    Args a{};
    for (int i = 0; i < 19; ++i) a.in[i] = (const float*)d_in[i];
    a.out = (float*)d_out; a.ws = (unsigned char*)d_ws;
    hipLaunchKernelGGL(mega_fwd, dim3(grid), dim3(NWAVES * 64), LDS_BYTES, stream, a);
}
```

```cpp
#include <hip/hip_runtime.h>
#include <cstdio>
#include <cstdint>
namespace pg8 {
#define PG8_LAS __attribute__((address_space(3)))
typedef unsigned short bf16_t;
typedef short bf16x8 __attribute__((ext_vector_type(8)));
typedef float f32x4 __attribute__((ext_vector_type(4)));
typedef unsigned u32x4 __attribute__((ext_vector_type(4)));
constexpr int BM = 256, BK = 64, HALF = 128, HTB = HALF * BK * 2  , STAGE_BYTES = 8 * HTB, NXCD = 8, WGM = 8;

__host__ __device__ __forceinline__ int lds_byte(int r, int c) { const int st = (r >> 4) * 2 + (c >> 5), rr = r & 15, cc = c & 31, ob = rr * 64 + cc * 2; return st * 1024 + (ob ^ (((ob >> 9) & 1) << 5)); }
__host__ __device__ __forceinline__ void stage_rc(int b, int& R, int& C) { const int st = b / 1024, sb = b % 1024, swz = sb ^ (((sb >> 9) & 1) << 5); R = (st >> 1) * 16 + swz / 64; C = (st & 1) * 32 + (swz % 64) / 2; }
__host__ __device__ __forceinline__ int perm32(int rho) { const int n = rho >> 4, i = rho & 15; return 8 * (i >> 2) + 4 * n + (i & 3); }

struct Unit { int pm, pn; };
struct Gemm { const bf16_t* A; const bf16_t* Bt; int M, N, K; };

struct StaticOrder {
    int nM, nN, nwg, G, c;
    __host__ __device__ void init(int M, int N, int G_, int c_) { nM = M / BM; nN = N / BM; nwg = nM * nN; G = G_; c = c_; }
    __host__ __device__ bool next(int i, Unit& u) const {
        const long L = (long)i * G + c; if (L >= nwg) return false;
        int wgid = (int)L; { const int q = nwg / NXCD, r = nwg % NXCD, xcd = wgid % NXCD, off = wgid / NXCD; wgid = (xcd < r ? xcd * (q + 1) : r * (q + 1) + (xcd - r) * q) + off; }
        const int nig = WGM * nN, gid = wgid / nig, fm = gid * WGM, gsz = (nM - fm) < WGM ? (nM - fm) : WGM;
        u.pm = fm + ((wgid % nig) % gsz); u.pn = (wgid % nig) / gsz; return true;
    }
    __device__ __forceinline__ void a_ready(const Unit&) const {}
    __device__ __forceinline__ void done(const Unit&) const {}
};

typedef float f32x2c __attribute__((ext_vector_type(2))); typedef __bf16 bf16x2c __attribute__((ext_vector_type(2)));
__device__ __forceinline__ unsigned cvt_pk_bf16(float lo, float hi) { f32x2c v = {lo, hi}; bf16x2c b = __builtin_convertvector(v, bf16x2c); return __builtin_bit_cast(unsigned, b); }
typedef float f32x2 __attribute__((ext_vector_type(2)));
template <class Epi, class Sched, bool ALIGN_EPI = false, bool SP2 = false>
__device__ __forceinline__ void gemm_phase(PG8_LAS unsigned char* lds, const Gemm g, const Sched& S, const Epi& E, const int wid_in) {
    int lane_l; asm volatile("v_mbcnt_lo_u32_b32 %0, -1, 0\n\tv_mbcnt_hi_u32_b32 %0, -1, %0" : "=v"(lane_l));
    const int tid = wid_in * 64 + lane_l, wid = wid_in, lane = tid & 63, wr = wid >> 2, wc = wid & 3, fr = lane & 15, fq = lane >> 4;
    const int K = g.K, nt = K / BK;
    unsigned voffA[2], voffB[2];
#pragma unroll
    for (int i = 0; i < 2; ++i) { int R, C; stage_rc(tid * 16 + i * 8192, R, C); const int Rb = Epi::PERM ? ((R & ~31) + perm32(R & 31)) : R;
        voffA[i] = (unsigned)(R * K + C) * 2u; voffB[i] = (unsigned)(Rb * K + C) * 2u; }
    const size_t kstep = (size_t)(BK * 2);
    const size_t hstep = (size_t)HALF * K * 2;
    const size_t tstep = 2 * hstep;
    const unsigned ldsw = (unsigned)wid * 1024u;
    const int aoff = lds_byte(wr * 64 + fr, fq * 8), boff = lds_byte(wc * 32 + fr, fq * 8);
#define PG8_SA(b, h) (((b) * 2 + (h)) * HTB)
#define PG8_SB(b, h) ((4 + (b) * 2 + (h)) * HTB)
#define PG8_STAGE(bufoff, gbase, voff) do { _Pragma("unroll") for (int _i = 0; _i < 2; ++_i) \
        __builtin_amdgcn_global_load_lds((const unsigned*)((const char*)(gbase) + (voff)[_i]), (PG8_LAS unsigned*)(lds + (bufoff) + ldsw + _i * 8192), 16, 0, 0); } while (0)
#define PG8_LDA(dst, b, h) do { _Pragma("unroll") for (int m = 0; m < 4; ++m) _Pragma("unroll") for (int k = 0; k < 2; ++k) dst[m][k] = *(const PG8_LAS bf16x8*)(lds + PG8_SA(b, h) + aoff + m * 2048 + k * 1024); } while (0)
#define PG8_LDB(dst, b, h) do { _Pragma("unroll") for (int n = 0; n < 2; ++n) _Pragma("unroll") for (int k = 0; k < 2; ++k) dst[n][k] = *(const PG8_LAS bf16x8*)(lds + PG8_SB(b, h) + boff + n * 2048 + k * 1024); } while (0)
#define PG8_MMA(ai, bj, At, Bt) do { __builtin_amdgcn_s_setprio(1); _Pragma("unroll") for (int m = 0; m < 4; ++m) _Pragma("unroll") for (int n = 0; n < 2; ++n) _Pragma("unroll") for (int k = 0; k < 2; ++k) \
        acc[ai][bj][m][n] = __builtin_amdgcn_mfma_f32_16x16x32_bf16(Bt[n][k], At[m][k], acc[ai][bj][m][n], 0, 0, 0); __builtin_amdgcn_s_setprio(0); } while (0)
#define PG8_WAIT_V(n) asm volatile("s_waitcnt vmcnt(" #n ")" ::: "memory")
#define PG8_WAIT_L(n) asm volatile("s_waitcnt lgkmcnt(" #n ")" ::: "memory")
#define PG8_BAR __builtin_amdgcn_s_barrier()
#define PG8_SCHED __builtin_amdgcn_sched_barrier(0)
    Unit cur, nxt; int ui = 0;
    if (!S.next(0, cur)) return;
    f32x4 acc[2][2][4][2];
#pragma unroll
    for (int a = 0; a < 2; ++a)
#pragma unroll
        for (int b = 0; b < 2; ++b)
#pragma unroll
            for (int m = 0; m < 4; ++m)
#pragma unroll
                for (int n = 0; n < 2; ++n) acc[a][b][m][n] = (f32x4){0.f, 0.f, 0.f, 0.f};
    bf16x8 At[4][2], B0[2][2], B1[2][2];
    const char* cA = (const char*)g.A + (size_t)cur.pm * tstep; const char* cB = (const char*)g.Bt + (size_t)cur.pn * tstep;
    S.a_ready(cur);
    if constexpr (SP2) {
        PG8_STAGE(PG8_SB(0, 0), cB, voffB); PG8_STAGE(PG8_SB(0, 1), cB + hstep, voffB); PG8_STAGE(PG8_SA(0, 0), cA, voffA); PG8_STAGE(PG8_SA(0, 1), cA + hstep, voffA);
        if (wr == 1) PG8_BAR;
        PG8_WAIT_V(2); PG8_BAR;
        PG8_STAGE(PG8_SB(1, 0), cB + kstep, voffB); PG8_STAGE(PG8_SA(1, 0), cA + kstep, voffA); PG8_STAGE(PG8_SB(1, 1), cB + hstep + kstep, voffB);
        PG8_WAIT_V(6); PG8_BAR;
    } else {
        PG8_STAGE(PG8_SB(0, 0), cB, voffB); PG8_STAGE(PG8_SA(0, 0), cA, voffA); PG8_STAGE(PG8_SB(0, 1), cB + hstep, voffB); PG8_STAGE(PG8_SA(0, 1), cA + hstep, voffA);
        if (wr == 1) PG8_BAR;
        PG8_WAIT_V(4); PG8_BAR;
        PG8_STAGE(PG8_SB(1, 0), cB + kstep, voffB); PG8_STAGE(PG8_SA(1, 0), cA + kstep, voffA); PG8_STAGE(PG8_SB(1, 1), cB + hstep + kstep, voffB);
        PG8_WAIT_V(6); PG8_BAR;
    }
    for (;;) {
        const bool has_next = S.next(ui + 1, nxt);
        const char* nA = has_next ? (const char*)g.A + (size_t)nxt.pm * tstep : cA; const char* nB = has_next ? (const char*)g.Bt + (size_t)nxt.pn * tstep : cB;
        for (int t = 0; t < nt; t += 2) {
            const bool last = (t == nt - 2);
            const char* a1 = cA + (size_t)(t + 1) * kstep;
            const char* a2 = last ? nA : cA + (size_t)(t + 2) * kstep; const char* b2 = last ? nB : cB + (size_t)(t + 2) * kstep;
            const char* a3 = a2 + kstep; const char* b3 = b2 + kstep;
            if (last && has_next) S.a_ready(nxt);
            if constexpr (SP2) {
            PG8_LDB(B0, 0, 0); PG8_LDB(B1, 0, 1); PG8_SCHED; PG8_LDA(At, 0, 0); PG8_STAGE(PG8_SA(1, 1), a1 + hstep, voffA);
            PG8_WAIT_V(8); PG8_WAIT_L(0); PG8_BAR; PG8_MMA(0, 0, At, B0); PG8_MMA(0, 1, At, B1); PG8_BAR; PG8_SCHED;
            PG8_LDA(At, 0, 1); PG8_STAGE(PG8_SB(0, 0), b2, voffB); PG8_STAGE(PG8_SB(0, 1), b2 + hstep, voffB); PG8_STAGE(PG8_SA(0, 0), a2, voffA);
            PG8_WAIT_V(8); PG8_WAIT_L(0); PG8_BAR; PG8_MMA(1, 0, At, B0); PG8_MMA(1, 1, At, B1); PG8_BAR; PG8_SCHED;
            PG8_LDB(B0, 1, 0); PG8_LDB(B1, 1, 1); PG8_SCHED; PG8_LDA(At, 1, 0); PG8_STAGE(PG8_SA(0, 1), a2 + hstep, voffA);
            PG8_WAIT_V(8); PG8_WAIT_L(0); PG8_BAR; PG8_MMA(0, 0, At, B0); PG8_MMA(0, 1, At, B1); PG8_BAR; PG8_SCHED;
            PG8_LDA(At, 1, 1); PG8_STAGE(PG8_SB(1, 0), b3, voffB); PG8_STAGE(PG8_SB(1, 1), b3 + hstep, voffB); PG8_STAGE(PG8_SA(1, 0), a3, voffA);
            PG8_WAIT_V(8); PG8_WAIT_L(0); PG8_BAR; PG8_MMA(1, 0, At, B0); PG8_MMA(1, 1, At, B1); PG8_BAR; PG8_SCHED;
            } else {
            PG8_LDB(B0, 0, 0); PG8_SCHED; PG8_LDA(At, 0, 0); PG8_STAGE(PG8_SA(1, 1), a1 + hstep, voffA);
            PG8_WAIT_L(8); PG8_BAR; PG8_WAIT_L(0); PG8_MMA(0, 0, At, B0); PG8_BAR; PG8_SCHED;
            PG8_LDB(B1, 0, 1); PG8_STAGE(PG8_SB(0, 0), b2, voffB);
            PG8_BAR; PG8_WAIT_L(0); PG8_MMA(0, 1, At, B1); PG8_BAR;
            PG8_LDA(At, 0, 1); PG8_STAGE(PG8_SA(0, 0), a2, voffA);
            PG8_BAR; PG8_WAIT_L(0); PG8_MMA(1, 0, At, B0); PG8_BAR; PG8_SCHED;
            PG8_STAGE(PG8_SB(0, 1), b2 + hstep, voffB);
            PG8_WAIT_V(6); PG8_BAR; PG8_MMA(1, 1, At, B1); PG8_BAR;
            PG8_LDB(B0, 1, 0); PG8_SCHED; PG8_LDA(At, 1, 0); PG8_STAGE(PG8_SA(0, 1), a2 + hstep, voffA);
            PG8_WAIT_L(8); PG8_BAR; PG8_WAIT_L(0); PG8_MMA(0, 0, At, B0); PG8_BAR; PG8_SCHED;
            PG8_LDB(B1, 1, 1); PG8_STAGE(PG8_SB(1, 0), b3, voffB);
            PG8_BAR; PG8_WAIT_L(0); PG8_MMA(0, 1, At, B1); PG8_BAR;
            PG8_LDA(At, 1, 1); PG8_STAGE(PG8_SA(1, 0), a3, voffA);
            PG8_BAR; PG8_WAIT_L(0); PG8_MMA(1, 0, At, B0); PG8_BAR; PG8_SCHED;
            PG8_STAGE(PG8_SB(1, 1), b3 + hstep, voffB);
            PG8_WAIT_V(6); PG8_BAR; PG8_MMA(1, 1, At, B1); PG8_BAR;
            }
        }
        if constexpr (ALIGN_EPI) { if (wr == 0) PG8_BAR; }
        if constexpr (!Epi::AFTER_DRAIN) { E(acc, cur, wr, wc, fr, fq); S.done(cur); }
        if (!has_next) break;
#pragma unroll
        for (int a = 0; a < 2; ++a)
#pragma unroll
            for (int b = 0; b < 2; ++b)
#pragma unroll
                for (int m = 0; m < 4; ++m)
#pragma unroll
                    for (int n = 0; n < 2; ++n) acc[a][b][m][n] = (f32x4){0.f, 0.f, 0.f, 0.f};
        cur = nxt; cA = nA; cB = nB; ++ui;
        if constexpr (ALIGN_EPI) { if (wr == 1) PG8_BAR; }
    }
    PG8_WAIT_V(0);
    if constexpr (!ALIGN_EPI) { if (wr == 0) PG8_BAR; }
    PG8_BAR;
    if constexpr (Epi::AFTER_DRAIN) { E.fused(acc, cur, wr, wc, fr, fq, lds, wid, lane); S.done(cur); }
#undef PG8_SA
#undef PG8_SB
#undef PG8_STAGE
#undef PG8_LDA
#undef PG8_LDB
#undef PG8_MMA
#undef PG8_WAIT_V
#undef PG8_WAIT_L
#undef PG8_BAR
#undef PG8_SCHED
}
}
#define GAS __attribute__((address_space(1)))
#define LAS __attribute__((address_space(3)))
typedef unsigned short bf16;
typedef unsigned v4u __attribute__((ext_vector_type(4)));
typedef float f32x4 __attribute__((ext_vector_type(4)));
typedef short bf16x8 __attribute__((ext_vector_type(8)));
typedef GAS unsigned gu32;
typedef GAS unsigned long long gu64;
#define RLX_AGENT __ATOMIC_RELAXED, __HIP_MEMORY_SCOPE_AGENT
#define LDS_WAIT() asm volatile("s_waitcnt lgkmcnt(0)" ::: "memory")
#define VM_WAIT() asm volatile("s_waitcnt vmcnt(0)" ::: "memory")
__device__ __forceinline__ unsigned long long rt() { return __builtin_amdgcn_s_memrealtime(); }
__device__ __forceinline__ unsigned f2bf(float f) { unsigned u = __builtin_bit_cast(unsigned, f); return (u + 0x7fffu + ((u >> 16) & 1u)) >> 16; }
__device__ __forceinline__ unsigned pk2(float lo, float hi) { return f2bf(lo) | (f2bf(hi) << 16); }

#define XB_TMO      128
#define XB_XCNT(j)  (256  + 64 * (j))
#define XB_XSUB(j)  (1280 + 64 * (j))
#define XB_XGEN(j)  (2304 + 64 * (j))
#define XB_TOP      3328
#define XB_TOPGEN   3392
#define XCD_BAR_WORDS 3456
#define XB_SPIN_CAP (1u << 18)

__device__ __forceinline__ unsigned xb_ld(unsigned* p)              { return __hip_atomic_load(p, __ATOMIC_RELAXED, __HIP_MEMORY_SCOPE_AGENT); }
__device__ __forceinline__ unsigned xb_add(unsigned* p, unsigned v) { return __hip_atomic_fetch_add(p, v, __ATOMIC_RELAXED, __HIP_MEMORY_SCOPE_AGENT); }
__device__ __forceinline__ unsigned xb_xcc_id() { return (unsigned)__builtin_amdgcn_s_getreg((3 << 11) | 20) & 0xFu; }
#define XB_SPIN(cond, bar) do { unsigned _sp = 0; while (cond) { __builtin_amdgcn_s_sleep(1); \
    if ((++_sp & 255u) == 0u) { if (xb_ld(&(bar)[XB_TMO])) break; if (_sp > XB_SPIN_CAP) { atomicAdd(&(bar)[XB_TMO], 1u); break; } } } } while (0)

struct XcdBarrier {
    unsigned* bar; unsigned x;
    volatile LAS unsigned* st;
};

__device__ __forceinline__ XcdBarrier xcd_barrier_post(unsigned* bar, volatile LAS unsigned* st) {
    XcdBarrier b; b.bar = bar; b.x = xb_xcc_id(); b.st = st;
    if (threadIdx.x == 0) (void)xb_add(&bar[XB_XCNT(b.x)], 1u);
    return b;
}
__device__ __forceinline__ void xcd_barrier_complete(unsigned* bar, unsigned x, unsigned& nloc, unsigned& nx) {
    const unsigned G = gridDim.x * gridDim.y * gridDim.z;
    unsigned sum, cnt, mine, sp = 0u;
    for (;;) {
        sum = 0u; cnt = 0u; mine = 0u;
#pragma unroll
        for (unsigned j = 0; j < 16; ++j) { const unsigned c = xb_ld(&bar[XB_XCNT(j)]); sum += c; cnt += (c > 0u) ? 1u : 0u; mine = (j == x) ? c : mine; }
        if (sum == G) break;
        __builtin_amdgcn_s_sleep(1);
        if ((++sp & 255u) == 0u) { if (xb_ld(&bar[XB_TMO])) break; if (sp > XB_SPIN_CAP) { atomicAdd(&bar[XB_TMO], 1u); break; } }
    }
    nloc = mine > 0u ? mine : 1u; nx = cnt > 0u ? cnt : 1u;
}

__device__ __forceinline__ void xcd_barrier(const XcdBarrier& b) {
    asm volatile("s_waitcnt vmcnt(0)" ::: "memory");
    __syncthreads();
    if (threadIdx.x == 0) {
        unsigned* bar = b.bar;
        __builtin_amdgcn_s_waitcnt(0);
        unsigned nloc = b.st[0], nx = b.st[1];
        if (nloc == 0u) { xcd_barrier_complete(bar, b.x, nloc, nx); b.st[0] = nloc; b.st[1] = nx; }
        const unsigned old = xb_add(&bar[XB_XSUB(b.x)], 1u);
        const unsigned gen = old / nloc;
        if (old + 1u == (gen + 1u) * nloc) {
            __builtin_amdgcn_fence(__ATOMIC_RELEASE, "agent");
            asm volatile("s_waitcnt vmcnt(0)" ::: "memory");
            const unsigned og = xb_add(&bar[XB_TOP], 1u);
            const unsigned tg = og / nx;
            if (og + 1u == (tg + 1u) * nx) xb_add(&bar[XB_TOPGEN], 1u);
            else XB_SPIN(xb_ld(&bar[XB_TOPGEN]) == tg, bar);
            __builtin_amdgcn_fence(__ATOMIC_ACQUIRE, "agent");
            xb_add(&bar[XB_XGEN(b.x)], 1u);
            asm volatile("s_waitcnt vmcnt(0)" ::: "memory");
        } else {
            XB_SPIN(xb_ld(&bar[XB_XGEN(b.x)]) == gen, bar);
            __builtin_amdgcn_fence(__ATOMIC_ACQUIRE, "agent");
            asm volatile("s_waitcnt vmcnt(0)" ::: "memory");
        }
    }
    __syncthreads();
}
constexpr int NWAVES = 8;
constexpr int D = 1024, MT = 16384, NCTX = 8192, NIN = 5664, DFF = 2816, N1P = 5888;
constexpr float EPSN = 1e-6f;
constexpr size_t MiB = 1u << 20;
constexpr size_t WS_CTL = 0, CTL_ZERO_BYTES = 1 * MiB;
constexpr size_t WS_WIN = 1 * MiB;
constexpr size_t WS_WFI = WS_WIN + (size_t)N1P * D * 2;
constexpr size_t WS_WFO = WS_WFI + (size_t)2 * DFF * D * 2;
constexpr size_t WS_WO = WS_WFO + (size_t)D * DFF * 2;
constexpr size_t WS_WBA = WS_WO + (size_t)D * D * 2;
constexpr size_t WS_WBB = WS_WBA + (size_t)D * 512 * 2;
static_assert(WS_WBB + (size_t)D * 512 * 2 == 33 * MiB, "weights fill [1,33) MiB");
constexpr size_t WS_H = 33 * MiB, WS_QKV = 65 * MiB, WS_Z = 113 * MiB, WS_CX = 129 * MiB, WS_BG = 145 * MiB, WS_GA = 161 * MiB, WS_GB = 193 * MiB, WS_BA = 225 * MiB, WS_OB = 227 * MiB;
constexpr size_t WS_OF = WS_H, WS_OBW = WS_H + 16 * MiB, WS_OA = WS_Z, WS_M = WS_QKV + 16 * MiB, WS_MIX = WS_Z, WS_ACT = WS_Z, WS_Y = WS_H, WS_END = 256 * MiB;
constexpr size_t WS_LPT = WS_H, WS_LRB = WS_H + 16 * MiB, WS_LSC = WS_QKV, WS_LDSC = 243 * MiB;
constexpr int CW_BAR = 4096;
constexpr int CW_MOD = 131072;
constexpr int RING_OFF = 0, RING_BYTES = 131072, LDSCTL_OFF = RING_BYTES, MISC_OFF = LDSCTL_OFF + 320, LDS_BYTES = 147456;

template <int CTRL> __device__ __forceinline__ float dpp_f(float v) { return __int_as_float(__builtin_amdgcn_update_dpp(0, __float_as_int(v), CTRL, 0xF, 0xF, true)); }
__device__ __forceinline__ float xor16_add(float v) { return v + __int_as_float(__builtin_amdgcn_ds_swizzle(__float_as_int(v), 0x401F)); }
__device__ __forceinline__ float xor32_add(float v) { auto rr = __builtin_amdgcn_permlane32_swap(__float_as_uint(v), __float_as_uint(v), false, false); return __uint_as_float(rr[0]) + __uint_as_float(rr[1]); }
__device__ __forceinline__ float wave_sum(float v) {
    v += dpp_f<0xB1>(v); v += dpp_f<0x4E>(v); v += dpp_f<0x141>(v); v += dpp_f<0x140>(v);
    return xor32_add(xor16_add(v));
}
__device__ __forceinline__ float bf2f(unsigned short b) { return __uint_as_float(((unsigned)b) << 16); }
__device__ __forceinline__ float bflo(unsigned w) { return __uint_as_float(w << 16); }
__device__ __forceinline__ float bfhi(unsigned w) { return __uint_as_float(w & 0xffff0000u); }
__device__ __forceinline__ float siluf(float x) { return x / (1.f + __expf(-x)); }
__device__ __forceinline__ float sigmf(float x) { return 1.f / (1.f + __expf(-x)); }
__device__ __forceinline__ float softplusf(float x) { return fmaxf(x, 0.f) + __logf(1.f + __expf(-fabsf(x))); }
__device__ __forceinline__ int lane_id_fresh() { int l; asm volatile("v_mbcnt_lo_u32_b32 %0, -1, 0\n\tv_mbcnt_hi_u32_b32 %0, -1, %0" : "=v"(l)); return l; }
__device__ __forceinline__ float rdl(float v, int l) { return __int_as_float(__builtin_amdgcn_readlane(__float_as_int(v), l)); }
__device__ __forceinline__ int mod_index(int r) { return r < NCTX ? 0 : 1 + (r - NCTX) / 2048; }

namespace pg8 {
__device__ __forceinline__ u32x4 pack8(const f32x4& v0, const f32x4& v1) { u32x4 w; w.x = cvt_pk_bf16(v0[0], v0[1]); w.y = cvt_pk_bf16(v0[2], v0[3]); w.z = cvt_pk_bf16(v1[0], v1[1]); w.w = cvt_pk_bf16(v1[2], v1[3]); return w; }
__device__ __forceinline__ f32x4 silu4(f32x4 v) { f32x4 o; for (int j = 0; j < 4; ++j) o[j] = v[j] / (1.f + __expf(-v[j])); return o; }
__device__ __forceinline__ f32x4 sigm4(f32x4 v) { f32x4 o; for (int j = 0; j < 4; ++j) o[j] = 1.f / (1.f + __expf(-v[j])); return o; }

struct EpiG1 {
    static constexpr bool PERM = true, AFTER_DRAIN = false;
    bf16_t *QKV, *Z, *CX, *BG, *GA, *GB; float* BA;
    __device__ __forceinline__ void operator()(const f32x4 (&acc)[2][2][4][2], const Unit& u, int wr, int wc, int fr_, int fq_) const {
        int fr = fr_, fq = fq_; asm volatile("" : "+v"(fr), "+v"(fq));
        const int row0 = u.pm * BM + wr * 64 + fr, c8 = wc * 32 + 8 * fq, pn = u.pn;
        if (pn == 22) {
            if (wc == 0) {
#pragma unroll
                for (int ai = 0; ai < 2; ++ai)
#pragma unroll
                    for (int m = 0; m < 4; ++m) { float* p = BA + (size_t)(row0 + ai * HALF + m * 16) * 32 + 8 * fq; *(f32x4*)p = acc[ai][0][m][0]; *(f32x4*)(p + 4) = acc[ai][0][m][1]; }
            }
            return;
        }
        if (pn >= 8 && pn < 12) {
#pragma unroll
            for (int ai = 0; ai < 2; ++ai)
#pragma unroll
                for (int m = 0; m < 4; ++m) { bf16_t* p = CX + (size_t)(row0 + ai * HALF + m * 16) * 512 + 128 * (pn - 8) + c8; *(u32x4*)p = pack8(acc[ai][0][m][0] * acc[ai][1][m][0], acc[ai][0][m][1] * acc[ai][1][m][1]); }
            return;
        }
        bf16_t* base; int ld, col0, mode;
        if (pn < 6) { base = QKV; ld = 1536; col0 = 256 * pn; mode = 0; }
        else if (pn < 8) { base = Z; ld = 512; col0 = 256 * (pn - 6); mode = 1; }
        else if (pn < 14) { base = BG; ld = 512; col0 = 256 * (pn - 12); mode = 0; }
        else if (pn < 18) { base = GA; ld = 1024; col0 = 256 * (pn - 14); mode = 2; }
        else { base = GB; ld = 1024; col0 = 256 * (pn - 18); mode = 2; }
#pragma unroll
        for (int ai = 0; ai < 2; ++ai)
#pragma unroll
            for (int m = 0; m < 4; ++m) { bf16_t* rowp = base + (size_t)(row0 + ai * HALF + m * 16) * ld + col0 + c8;
#pragma unroll
                for (int bj = 0; bj < 2; ++bj) { f32x4 v0 = acc[ai][bj][m][0], v1 = acc[ai][bj][m][1];
                    if (mode == 1) { v0 = silu4(v0); v1 = silu4(v1); }
                    if (mode == 2) { v0 = sigm4(v0); v1 = sigm4(v1); }
                    *(u32x4*)(rowp + bj * HALF) = pack8(v0, v1); } }
    }
};
struct EpiFfnIn {
    static constexpr bool PERM = true, AFTER_DRAIN = false;
    bf16_t* ACT;
    __device__ __forceinline__ void operator()(const f32x4 (&acc)[2][2][4][2], const Unit& u, int wr, int wc, int fr_, int fq_) const {
        int fr = fr_, fq = fq_; asm volatile("" : "+v"(fr), "+v"(fq));
        const int row0 = u.pm * BM + wr * 64 + fr, c8 = wc * 32 + 8 * fq;
#pragma unroll
        for (int ai = 0; ai < 2; ++ai)
#pragma unroll
            for (int m = 0; m < 4; ++m) { bf16_t* p = ACT + (size_t)(row0 + ai * HALF + m * 16) * DFF + 128 * u.pn + c8;
                *(u32x4*)p = pack8(silu4(acc[ai][0][m][0]) * acc[ai][1][m][0], silu4(acc[ai][0][m][1]) * acc[ai][1][m][1]); }
    }
};
template <int PASS> struct EpiBr {
    static constexpr bool PERM = true, AFTER_DRAIN = false;
    bf16_t* Mb; const bf16_t* G;
    __device__ __forceinline__ void operator()(const f32x4 (&acc)[2][2][4][2], const Unit& u, int wr, int wc, int fr_, int fq_) const {
        int fr = fr_, fq = fq_; asm volatile("" : "+v"(fr), "+v"(fq));
        const int row0 = u.pm * BM + wr * 64 + fr, c8 = u.pn * BM + wc * 32 + 8 * fq;
#pragma unroll
        for (int ai = 0; ai < 2; ++ai)
#pragma unroll
            for (int m = 0; m < 4; ++m)
#pragma unroll
                for (int bj = 0; bj < 2; ++bj) { const size_t off = (size_t)(row0 + ai * HALF + m * 16) * D + c8 + bj * HALF;
                    const u32x4 g = *(const u32x4*)(G + off); f32x4 v0 = acc[ai][bj][m][0], v1 = acc[ai][bj][m][1];
                    v0[0] *= bflo(g.x); v0[1] *= bfhi(g.x); v0[2] *= bflo(g.y); v0[3] *= bfhi(g.y); v1[0] *= bflo(g.z); v1[1] *= bfhi(g.z); v1[2] *= bflo(g.w); v1[3] *= bfhi(g.w);
                    if (PASS == 1) { const u32x4 o = *(const u32x4*)(Mb + off); v0[0] += bflo(o.x); v0[1] += bfhi(o.x); v0[2] += bflo(o.y); v0[3] += bfhi(o.y); v1[0] += bflo(o.z); v1[1] += bfhi(o.z); v1[2] += bflo(o.w); v1[3] += bfhi(o.w); }
                    *(u32x4*)(Mb + off) = pack8(v0, v1); }
    }
};
struct EpiF32 {
    static constexpr bool PERM = false, AFTER_DRAIN = false;
    float* C; int ldc;
    __device__ __forceinline__ void operator()(const f32x4 (&acc)[2][2][4][2], const Unit& u, int wr, int wc, int fr_, int fq_) const {
        int fr = fr_, fq = fq_; asm volatile("" : "+v"(fr), "+v"(fq));
        const int row0 = u.pm * BM + wr * 64 + fr, col0 = u.pn * BM + wc * 32 + 4 * fq;
#pragma unroll
        for (int ai = 0; ai < 2; ++ai)
#pragma unroll
            for (int m = 0; m < 4; ++m) { float* rowp = C + (size_t)(row0 + ai * HALF + m * 16) * ldc + col0;
#pragma unroll
                for (int bj = 0; bj < 2; ++bj)
#pragma unroll
                    for (int n = 0; n < 2; ++n) *(f32x4*)(rowp + bj * HALF + n * 16) = acc[ai][bj][m][n]; }
    }
};
}

struct Frame {
    LAS unsigned char* lds; volatile LAS unsigned* MISC; gu32* ctl;
    int tid, lane, wave, vcu, G;
    float* out; unsigned char* ws;
};
__device__ __forceinline__ const float* in_ptr(int i) {
    const float* p; asm volatile("s_load_dwordx2 %0, %1, %2\n\ts_waitcnt lgkmcnt(0)" : "=s"(p) : "s"(__builtin_amdgcn_kernarg_segment_ptr()), "s"(i * 8)); return p; }
enum { I_XP = 0, I_XS, I_STATE, I_C, I_CCTX, I_WMOD, I_BMOD, I_GAINS, I_WIN, I_CONVQKV, I_ALOG, I_DTB, I_ONORM, I_CONVSC, I_WBRA, I_WBRB, I_WOUT, I_WFI, I_WFO };
__device__ __forceinline__ const float* xrow(const float* xp, const float* xs, int r) { return r < NCTX ? xp + (size_t)r * D : xs + (size_t)(r - NCTX) * D; }

__device__ __forceinline__ void transpose_item(const float* W, int K, int N, bf16* WT, int src_col0, int dst_row0, int k0, LAS float* scr, int lane) {
#pragma unroll 8
    for (int i = 0; i < 32; ++i) { const int kk = 2 * i + (lane >> 5); scr[kk * 33 + (lane & 31)] = W[(size_t)(k0 + kk) * N + src_col0 + (lane & 31)]; }
    LDS_WAIT(); asm volatile("" ::: "memory");
    const int c = lane & 7;
#pragma unroll
    for (int j = 0; j < 4; ++j) { const int n = (lane >> 3) + 8 * j; const LAS float* s = scr + (8 * c) * 33 + n;
        v4u o; o.x = pk2(s[0 * 33], s[1 * 33]); o.y = pk2(s[2 * 33], s[3 * 33]); o.z = pk2(s[4 * 33], s[5 * 33]); o.w = pk2(s[6 * 33], s[7 * 33]);
        *(GAS v4u*)(WT + (size_t)(dst_row0 + n) * K + k0 + 8 * c) = o; }
    LDS_WAIT(); asm volatile("" ::: "memory");
}
__device__ __forceinline__ void zero_item(bf16* WT, int K, int dst_row0, int k0, int lane) {
    const int c = lane & 7;
#pragma unroll
    for (int j = 0; j < 4; ++j) { const int n = (lane >> 3) + 8 * j; *(GAS v4u*)(WT + (size_t)(dst_row0 + n) * K + k0 + 8 * c) = (v4u){0u, 0u, 0u, 0u}; }
}
__device__ __forceinline__ int win_src(int d0) {
    if (d0 < 2048) return d0;
    if (d0 < 3072) { const int t = d0 - 2048, i = t >> 8, w = t & 255; return w < 128 ? 2592 + 128 * i + w : 3104 + 128 * i + (w - 128); }
    if (d0 < 3584) return 2080 + (d0 - 3072);
    if (d0 < 4608) return 3616 + (d0 - 3584);
    if (d0 < 5632) return 4640 + (d0 - 4608);
    if (d0 == 5632) return 2048;
    return -1;
}
__device__ __forceinline__ void p0_prologue(Frame& F) {
    const float* w_mod = in_ptr(I_WMOD); const float* c_ctx = in_ptr(I_CCTX); const float* cvec = in_ptr(I_C); const float* b_mod = in_ptr(I_BMOD);
    LAS float* scr = (LAS float*)(F.lds + RING_OFF + F.wave * 16384);
    const int gw = F.vcu * NWAVES + F.wave, NGW = F.G * NWAVES;
    bf16* WIN = (bf16*)(F.ws + WS_WIN); bf16* WFI = (bf16*)(F.ws + WS_WFI); bf16* WFO = (bf16*)(F.ws + WS_WFO); bf16* WO = (bf16*)(F.ws + WS_WO); bf16* WBA = (bf16*)(F.ws + WS_WBA); bf16* WBB = (bf16*)(F.ws + WS_WBB);
    constexpr int I_IN = (N1P / 32) * 16, I_FI = (2 * DFF / 32) * 16, I_FO = (D / 32) * (DFF / 64), I_O = (D / 32) * 16, I_B = (D / 32) * 8;
    constexpr int NITEMS = I_IN + I_FI + I_FO + I_O + 2 * I_B;
    for (int it = gw; it < NITEMS; it += NGW) {
        int r = it;
        if (r < I_IN) { const int nb = r >> 4, kb = r & 15, src = win_src(32 * nb); if (src >= 0) transpose_item(in_ptr(I_WIN), D, NIN, WIN, src, 32 * nb, 64 * kb, scr, F.lane); else zero_item(WIN, D, 32 * nb, 64 * kb, F.lane); continue; } r -= I_IN;
        if (r < I_FI) { const int nb = r >> 4, kb = r & 15, d0 = 32 * nb, i = d0 >> 8, w = d0 & 255, src = w < 128 ? 128 * i + w : DFF + 128 * i + (w - 128); transpose_item(in_ptr(I_WFI), D, 2 * DFF, WFI, src, d0, 64 * kb, scr, F.lane); continue; } r -= I_FI;
        if (r < I_FO) { const int nb = r / (DFF / 64), kb = r % (DFF / 64); transpose_item(in_ptr(I_WFO), DFF, D, WFO, 32 * nb, 32 * nb, 64 * kb, scr, F.lane); continue; } r -= I_FO;
        if (r < I_O) { const int nb = r >> 4, kb = r & 15; transpose_item(in_ptr(I_WOUT), D, D, WO, 32 * nb, 32 * nb, 64 * kb, scr, F.lane); continue; } r -= I_O;
        if (r < I_B) { const int nb = r >> 3, kb = r & 7; transpose_item(in_ptr(I_WBRA), 512, D, WBA, 32 * nb, 32 * nb, 64 * kb, scr, F.lane); continue; } r -= I_B;
        { const int nb = r >> 3, kb = r & 7; transpose_item(in_ptr(I_WBRB), 512, D, WBB, 32 * nb, 32 * nb, 64 * kb, scr, F.lane); }
    }
    float* mod = (float*)(F.ctl + CW_MOD);
    for (int it = gw; it < 24 * 32; it += NGW) {
        const int cg = it % 24, ks = it / 24, col = 256 * cg + 4 * F.lane;
        f32x4 acc[5];
#pragma unroll
        for (int r = 0; r < 5; ++r) acc[r] = (f32x4){0.f, 0.f, 0.f, 0.f};
#pragma unroll 8
        for (int kk = 0; kk < 32; ++kk) { const int k = 32 * ks + kk; const f32x4 w = *(const GAS f32x4*)(w_mod + (size_t)k * 6144 + col);
            acc[0] += siluf(c_ctx[k]) * w;
#pragma unroll
            for (int b = 0; b < 4; ++b) acc[1 + b] += siluf(cvec[b * D + k]) * w; }
        if (ks == 0) { const f32x4 bm = *(const GAS f32x4*)(b_mod + col);
#pragma unroll
            for (int r = 0; r < 5; ++r) acc[r] += bm; }
#pragma unroll
        for (int r = 0; r < 5; ++r)
#pragma unroll
            for (int e = 0; e < 4; ++e) atomicAdd(mod + r * 6144 + col + e, acc[r][e]);
    }
}
__device__ __forceinline__ void p1_norm_rows(Frame& F) {
    const float* gains = in_ptr(I_GAINS); const float* xp = in_ptr(I_XP); const float* xs = in_ptr(I_XS);
    const int gw = F.vcu * NWAVES + F.wave, NGW = F.G * NWAVES;
    const float* mod = (const float*)(F.ctl + CW_MOD); bf16* H = (bf16*)(F.ws + WS_H);
    for (int r = gw; r < MT; r += NGW) {
        const GAS f32x4* xr = (const GAS f32x4*)xrow(xp, xs, r) + F.lane; const float* m = mod + mod_index(r) * 6144;
        f32x4 v[4]; float s = 0.f;
#pragma unroll
        for (int j = 0; j < 4; ++j) { v[j] = xr[64 * j]; s += (v[j].x * v[j].x + v[j].y * v[j].y) + (v[j].z * v[j].z + v[j].w * v[j].w); }
        const float rstd = rsqrtf(wave_sum(s) * (1.f / D) + EPSN);
        GAS unsigned long long* o8 = (GAS unsigned long long*)(H + (size_t)r * D) + F.lane;
#pragma unroll
        for (int j = 0; j < 4; ++j) { const int k = 4 * F.lane + 256 * j; const f32x4 g = *(const GAS f32x4*)(gains + k), sc = *(const f32x4*)(m + 1024 + k), sh = *(const f32x4*)(m + k);
            const f32x4 h = v[j] * rstd * g * (sc + 1.f) + sh;
            o8[64 * j] = (unsigned long long)pk2(h.x, h.y) | ((unsigned long long)pk2(h.z, h.w) << 32); }
    }
}
__device__ __forceinline__ void ob_phase(Frame& F) {
    const float* conv_sc = in_ptr(I_CONVSC);
    const bf16* CX = (const bf16*)(F.ws + WS_CX); const bf16* BG = (const bf16*)(F.ws + WS_BG); bf16* OB = (bf16*)(F.ws + WS_OB);
    const int gt = (F.vcu * NWAVES + F.wave) * 64 + F.lane, NGT = F.G * NWAVES * 64;
    for (int idx = gt; idx < MT * 64; idx += NGT) {
        const int r = idx >> 6, j0 = (idx & 63) * 8; const int seglen = r < NCTX ? 256 : 64, pos = r % seglen;
        float acc[8];
#pragma unroll
        for (int e = 0; e < 8; ++e) acc[e] = 0.f;
#pragma unroll
        for (int tp = 0; tp < 3; ++tp) { const int pp = pos + tp - 1;
            if (pp >= 0 && pp < seglen) { const v4u cv = *(const GAS v4u*)(CX + (size_t)(r + tp - 1) * 512 + j0); const f32x4 w0 = *(const GAS f32x4*)(conv_sc + tp * 512 + j0), w1 = *(const GAS f32x4*)(conv_sc + tp * 512 + j0 + 4);
                acc[0] += w0.x * bflo(cv.x); acc[1] += w0.y * bfhi(cv.x); acc[2] += w0.z * bflo(cv.y); acc[3] += w0.w * bfhi(cv.y); acc[4] += w1.x * bflo(cv.z); acc[5] += w1.y * bfhi(cv.z); acc[6] += w1.z * bflo(cv.w); acc[7] += w1.w * bfhi(cv.w); } }
        const v4u bg = *(const GAS v4u*)(BG + (size_t)r * 512 + j0);
        v4u o; o.x = pk2(acc[0] * bflo(bg.x), acc[1] * bfhi(bg.x)); o.y = pk2(acc[2] * bflo(bg.y), acc[3] * bfhi(bg.y)); o.z = pk2(acc[4] * bflo(bg.z), acc[5] * bfhi(bg.z)); o.w = pk2(acc[6] * bflo(bg.w), acc[7] * bfhi(bg.w));
        *(GAS v4u*)(OB + (size_t)r * 512 + j0) = o;
    }
}
__device__ __forceinline__ void resnorm_phase(Frame& F) {
    const float* gains = in_ptr(I_GAINS); const float* xp = in_ptr(I_XP); const float* xs = in_ptr(I_XS);
    const int gw = F.vcu * NWAVES + F.wave, NGW = F.G * NWAVES;
    const float* mod = (const float*)(F.ctl + CW_MOD); const float* MIX = (const float*)(F.ws + WS_MIX); bf16* H = (bf16*)(F.ws + WS_H);
    for (int r = gw; r < MT; r += NGW) {
        const GAS f32x4* xr = (const GAS f32x4*)xrow(xp, xs, r) + F.lane; const GAS f32x4* mr = (const GAS f32x4*)(MIX + (size_t)r * D) + F.lane; const float* m = mod + mod_index(r) * 6144;
        f32x4 v[4]; float s = 0.f;
#pragma unroll
        for (int j = 0; j < 4; ++j) { v[j] = mr[64 * j]; s += (v[j].x * v[j].x + v[j].y * v[j].y) + (v[j].z * v[j].z + v[j].w * v[j].w); }
        const float rstd = rsqrtf(wave_sum(s) * (1.f / D) + EPSN); float s2 = 0.f;
        GAS f32x4* orow = (GAS f32x4*)(F.out + (size_t)r * D) + F.lane;
#pragma unroll
        for (int j = 0; j < 4; ++j) { const int k = 4 * F.lane + 256 * j; const f32x4 g = *(const GAS f32x4*)(gains + 1024 + k), gt = *(const f32x4*)(m + 2048 + k);
            v[j] = xr[64 * j] + gt * (v[j] * rstd * g); s2 += (v[j].x * v[j].x + v[j].y * v[j].y) + (v[j].z * v[j].z + v[j].w * v[j].w); orow[64 * j] = v[j]; }
        const float rstd2 = rsqrtf(wave_sum(s2) * (1.f / D) + EPSN);
        GAS unsigned long long* o8 = (GAS unsigned long long*)(H + (size_t)r * D) + F.lane;
#pragma unroll
        for (int j = 0; j < 4; ++j) { const int k = 4 * F.lane + 256 * j; const f32x4 g = *(const GAS f32x4*)(gains + 2048 + k), sc = *(const f32x4*)(m + 4096 + k), sh = *(const f32x4*)(m + 3072 + k);
            const f32x4 h = v[j] * rstd2 * g * (sc + 1.f) + sh;
            o8[64 * j] = (unsigned long long)pk2(h.x, h.y) | ((unsigned long long)pk2(h.z, h.w) << 32); }
    }
}
__device__ __forceinline__ void final_phase(Frame& F) {
    const float* gains = in_ptr(I_GAINS);
    const int gw = F.vcu * NWAVES + F.wave, NGW = F.G * NWAVES;
    const float* mod = (const float*)(F.ctl + CW_MOD); const float* Y = (const float*)(F.ws + WS_Y);
    for (int r = gw; r < MT; r += NGW) {
        const GAS f32x4* yr = (const GAS f32x4*)(Y + (size_t)r * D) + F.lane; const float* m = mod + mod_index(r) * 6144;
        f32x4 v[4]; float s = 0.f;
#pragma unroll
        for (int j = 0; j < 4; ++j) { v[j] = yr[64 * j]; s += (v[j].x * v[j].x + v[j].y * v[j].y) + (v[j].z * v[j].z + v[j].w * v[j].w); }
        const float rstd = rsqrtf(wave_sum(s) * (1.f / D) + EPSN);
        GAS f32x4* orow = (GAS f32x4*)(F.out + (size_t)r * D) + F.lane;
#pragma unroll
        for (int j = 0; j < 4; ++j) { const int k = 4 * F.lane + 256 * j; const f32x4 g = *(const GAS f32x4*)(gains + 3072 + k), gt = *(const f32x4*)(m + 5120 + k);
            orow[64 * j] = orow[64 * j] + gt * (v[j] * rstd * g); }
    }
}

typedef unsigned u32x2 __attribute__((ext_vector_type(2)));
typedef short v4i16_t __attribute__((ext_vector_type(4)));
typedef float f32x2_t __attribute__((ext_vector_type(2))); typedef __bf16 bf16x2_t __attribute__((ext_vector_type(2)));
__device__ __forceinline__ unsigned cvtpk(float lo, float hi) { f32x2_t v = {lo, hi}; bf16x2_t b = __builtin_convertvector(v, bf16x2_t); return __builtin_bit_cast(unsigned, b); }
__device__ __forceinline__ u32x2 pack4(f32x4 v) { return (u32x2){cvtpk(v[0], v[1]), cvtpk(v[2], v[3])}; }
__device__ __forceinline__ f32x4 unpack4(u32x2 w) { return (f32x4){bflo(w.x), bfhi(w.x), bflo(w.y), bfhi(w.y)}; }
__device__ __forceinline__ u32x2 neg4(u32x2 w) { return (u32x2){w.x ^ 0x80008000u, w.y ^ 0x80008000u}; }
__device__ __forceinline__ f32x4 mm(u32x2 a0, u32x2 a1, u32x2 b0, u32x2 b1, f32x4 cacc) {
    return __builtin_amdgcn_mfma_f32_16x16x32_bf16(__builtin_bit_cast(bf16x8, (v4u){a0.x, a0.y, a1.x, a1.y}), __builtin_bit_cast(bf16x8, (v4u){b0.x, b0.y, b1.x, b1.y}), cacc, 0, 0, 0);
}
__device__ __forceinline__ f32x4 mmv(v4u a, v4u b, f32x4 cacc) { return __builtin_amdgcn_mfma_f32_16x16x32_bf16(__builtin_bit_cast(bf16x8, a), __builtin_bit_cast(bf16x8, b), cacc, 0, 0, 0); }
__device__ __forceinline__ u32x2 tr_read(const LAS unsigned char* p) { return __builtin_bit_cast(u32x2, __builtin_amdgcn_ds_read_tr16_b64_v4i16((LAS v4i16_t*)p)); }
constexpr int IMG_ROW = 160;
constexpr int IMG_BYTES = 64 * IMG_ROW;
constexpr int DSCR_OFF = 8 * IMG_BYTES, DSCR_BYTES = 4608;
static_assert(DSCR_OFF + 8 * DSCR_BYTES <= RING_BYTES, "delta LDS map");

__device__ __forceinline__ f32x4 conv_silu4(const bf16* QKV, const float* cw, size_t rowoff, int col, bool vprev, bool vnext) {
    const u32x2 x0 = *(const GAS u32x2*)(QKV + rowoff + col);
    u32x2 xm = (u32x2){0u, 0u}, xp = (u32x2){0u, 0u};
    if (vprev) xm = *(const GAS u32x2*)(QKV + rowoff - 1536 + col);
    if (vnext) xp = *(const GAS u32x2*)(QKV + rowoff + 1536 + col);
    const f32x4 w0 = *(const GAS f32x4*)(cw + col), w1 = *(const GAS f32x4*)(cw + 1536 + col), w2 = *(const GAS f32x4*)(cw + 3072 + col);
    f32x4 v = w0 * unpack4(xm) + w1 * unpack4(x0) + w2 * unpack4(xp);
#pragma unroll
    for (int e = 0; e < 4; ++e) v[e] = v[e] / (1.f + __expf(-v[e]));
    return v;
}
__device__ __forceinline__ void load_frag_norm(const bf16* QKV, const float* cw_, size_t rowoff, int colbase, bool vprev, bool vnext, float scale, u32x2 (&fr)[4]) {
    const float* cw = cw_; asm volatile("" : "+s"(cw));
    f32x4 v[4]; float ss = 0.f;
#pragma unroll
    for (int dq = 0; dq < 4; ++dq) { v[dq] = conv_silu4(QKV, cw, rowoff, colbase + 16 * dq, vprev, vnext); ss += (v[dq][0] * v[dq][0] + v[dq][1] * v[dq][1]) + (v[dq][2] * v[dq][2] + v[dq][3] * v[dq][3]); }
    ss = xor32_add(xor16_add(ss));
    const float rn = rsqrtf(ss + EPSN) * scale;
#pragma unroll
    for (int dq = 0; dq < 4; ++dq) fr[dq] = pack4(v[dq] * rn);
}

template <int MODE>
__device__ __forceinline__ void delta_tile(Frame& F, int tile) {
    const float* conv_qkv = in_ptr(I_CONVQKV);
    const int lane = lane_id_fresh(), g = lane >> 4, c = lane & 15, w = F.wave, d = w >> 2, q = w & 3, cch = d ? 3 - q : q;
    const int b = MODE == 0 ? tile >> 3 : tile >> 6, h = MODE == 0 ? tile & 7 : (tile >> 3) & 7, sgm = tile & 7;
    const int crow0 = MODE == 0 ? b * 256 + 64 * cch : NCTX + b * 2048 + 256 * sgm + 64 * cch;
    const int litem = ((b * 8 + h) * 2 + d) * 32 + (d ? 31 - (4 * sgm + cch) : 4 * sgm + cch);
    const bf16* QKV = (const bf16*)(F.ws + WS_QKV); const float* BA = (const float*)(F.ws + WS_BA);
    LAS unsigned char* KIMG = F.lds + cch * (2 * IMG_BYTES); LAS unsigned char* VIMG = KIMG + IMG_BYTES;
    LAS unsigned char* SCR = F.lds + DSCR_OFF + w * DSCR_BYTES;
    LAS float* LTd = (LAS float*)SCR; LAS float* TABg = (LAS float*)(SCR + 4096); LAS float* TABb = TABg + 64;
    const u32x2 Z2 = (u32x2){0u, 0u};
    {   const int tau = d ? 63 - lane : lane; const size_t r = (size_t)(crow0 + tau);
        const float braw = BA[r * 32 + d * 8 + h], araw = BA[r * 32 + 16 + d * 8 + h];
        float x = -__expf(in_ptr(I_ALOG)[d * 8 + h]) * softplusf(araw + in_ptr(I_DTB)[d * 8 + h]);
#pragma unroll
        for (int o = 1; o < 64; o <<= 1) { const float y = __int_as_float(__builtin_amdgcn_ds_bpermute(((lane - o) & 63) << 2, __float_as_int(x))); if (lane >= o) x += y; }
        TABg[lane] = x; TABb[lane] = sigmf(braw); }
    u32x2 Kf[4][4];
#pragma unroll
    for (int t = 0; t < 4; ++t) {
        const int tau = d ? 63 - (16 * t + c) : 16 * t + c, p = 64 * cch + tau; const bool vprev = MODE == 0 ? p > 0 : tau > 0, vnext = MODE == 0 ? p < 255 : tau < 63;
        const size_t rowoff = (size_t)(crow0 + tau) * 1536;
        load_frag_norm(QKV, conv_qkv, rowoff, 512 + h * 64 + 4 * g, vprev, vnext, 1.f, Kf[t]);
        if (t < 2) {
#pragma unroll
            for (int dq = 0; dq < 4; ++dq) {
                *(LAS u32x2*)(KIMG + tau * IMG_ROW + (16 * dq + 4 * g) * 2) = Kf[t][dq];
                *(LAS u32x2*)(VIMG + tau * IMG_ROW + (16 * dq + 4 * g) * 2) = pack4(conv_silu4(QKV, conv_qkv, rowoff, 1024 + h * 64 + 16 * dq + 4 * g, vprev, vnext)); }
        }
        __builtin_amdgcn_sched_barrier(0);
    }
    __syncthreads();
    __builtin_amdgcn_sched_barrier(0);
    float gci[4], bti[4]; f32x4 gcj[4];
#pragma unroll
    for (int t = 0; t < 4; ++t) { gci[t] = TABg[16 * t + c]; bti[t] = TABb[16 * t + c]; gcj[t] = *(const LAS f32x4*)(TABg + 16 * t + 4 * g); }
    const float glast = TABg[63];
    u32x2 Lf[4][3];
#pragma unroll
    for (int it = 0; it < 4; ++it)
#pragma unroll
        for (int jt = 0; jt <= it; ++jt) {
            f32x4 kk = mm(Kf[jt][0], Kf[jt][1], Kf[it][0], Kf[it][1], (f32x4){0.f, 0.f, 0.f, 0.f}); kk = mm(Kf[jt][2], Kf[jt][3], Kf[it][2], Kf[it][3], kk);
            f32x4 lv;
#pragma unroll
            for (int r = 0; r < 4; ++r) { const float dec = __expf(gci[it] - gcj[jt][r]); const bool lm = (jt < it) || (c > 4 * g + r); lv[r] = lm ? bti[it] * kk[r] * dec : 0.f; }
            if (jt < it) Lf[it][jt] = pack4(-lv);
            else {
#pragma unroll
                for (int r = 0; r < 4; ++r) LTd[(it * 16 + 4 * g + r) * 16 + c] = lv[r]; }
        }
    u32x2 Tf[4];
    {   float X[16];
#pragma unroll
        for (int m = 0; m < 16; ++m) X[m] = (m == c) ? 1.f : 0.f;
#pragma unroll
        for (int j = 14; j >= 0; --j) {
            float sum = 0.f;
#pragma unroll
            for (int m4 = (j + 1) / 4; m4 < 4; ++m4) { const f32x4 l = *(const LAS f32x4*)(LTd + (g * 16 + j) * 16 + 4 * m4);
#pragma unroll
                for (int e = 0; e < 4; ++e) if (4 * m4 + e > j) sum += X[4 * m4 + e] * l[e]; }
            X[j] = (j == c) ? 1.f : -sum;
        }
        LAS unsigned char* TI = SCR;
        *(LAS v4u*)(TI + (g * 16 + c) * 32) = (v4u){cvtpk(X[0], X[1]), cvtpk(X[2], X[3]), cvtpk(X[4], X[5]), cvtpk(X[6], X[7])};
        *(LAS v4u*)(TI + (g * 16 + c) * 32 + 16) = (v4u){cvtpk(X[8], X[9]), cvtpk(X[10], X[11]), cvtpk(X[12], X[13]), cvtpk(X[14], X[15])};
#pragma unroll
        for (int bb = 0; bb < 4; ++bb) Tf[bb] = *(const LAS u32x2*)(TI + (bb * 16 + c) * 32 + 8 * g);
    }
    u32x2 Xb[4][8];
#pragma unroll
    for (int bi = 0; bi < 4; ++bi) {
        const f32x4 btj = *(const LAS f32x4*)(TABb + 16 * bi + 4 * g); f32x4 egj;
#pragma unroll
        for (int r = 0; r < 4; ++r) egj[r] = __expf(gcj[bi][r]) * btj[r];
        const int base_row = d ? 60 - 16 * bi - 4 * g : 16 * bi + 4 * g;
#pragma unroll
        for (int nt = 0; nt < 8; ++nt) {
            const LAS unsigned char* img = (nt < 4) ? VIMG : KIMG;
            f32x4 v = unpack4(tr_read(img + (base_row + (c >> 2)) * IMG_ROW + (16 * (nt & 3) + 4 * (c & 3)) * 2));
            if (d) v = (f32x4){v[3], v[2], v[1], v[0]};
            f32x4 acc = v * (nt < 4 ? btj : egj);
            if (bi == 1) acc = mm(Lf[1][0], Z2, Xb[0][nt], Z2, acc);
            if (bi == 2) acc = mm(Lf[2][0], Lf[2][1], Xb[0][nt], Xb[1][nt], acc);
            if (bi == 3) { acc = mm(Lf[3][0], Lf[3][1], Xb[0][nt], Xb[1][nt], acc); acc = mm(Lf[3][2], Z2, Xb[2][nt], Z2, acc); }
            Xb[bi][nt] = pack4(mm(Tf[bi], Z2, pack4(acc), Z2, (f32x4){0.f, 0.f, 0.f, 0.f}));
            asm volatile("" : "+v"(Xb[bi][nt]));
        }
    }
    u32x2 Qf[4][4], Af[4][4]; float gci2[4];
    if constexpr (MODE != 1) {
    __builtin_amdgcn_sched_barrier(0);
    f32x4 gcj2[4];
#pragma unroll
    for (int t = 0; t < 4; ++t) { gci2[t] = gci[t]; gcj2[t] = gcj[t]; asm volatile("" : "+v"(gci2[t]), "+v"(gcj2[t])); }
    {   const int lane2 = lane_id_fresh(), g2 = lane2 >> 4, c2 = lane2 & 15;
#pragma unroll
        for (int t = 0; t < 4; ++t) {
            const int tau = d ? 63 - (16 * t + c2) : 16 * t + c2, p = 64 * cch + tau;
            load_frag_norm(QKV, conv_qkv, (size_t)(crow0 + tau) * 1536, h * 64 + 4 * g2, MODE == 0 ? p > 0 : tau > 0, MODE == 0 ? p < 255 : tau < 63, 0.125f, Qf[t]);
            __builtin_amdgcn_sched_barrier(0);
        }
#pragma unroll
        for (int t = 0; t < 4; ++t) {
            const int tau = d ? 63 - (16 * t + c2) : 16 * t + c2;
#pragma unroll
            for (int dq = 0; dq < 4; ++dq) Kf[t][dq] = *(const LAS u32x2*)(KIMG + tau * IMG_ROW + (16 * dq + 4 * g2) * 2); }
    }
#pragma unroll
    for (int it = 0; it < 4; ++it)
#pragma unroll
        for (int jt = 0; jt <= it; ++jt) {
            f32x4 qk = mm(Kf[jt][0], Kf[jt][1], Qf[it][0], Qf[it][1], (f32x4){0.f, 0.f, 0.f, 0.f}); qk = mm(Kf[jt][2], Kf[jt][3], Qf[it][2], Qf[it][3], qk);
            f32x4 av;
#pragma unroll
            for (int r = 0; r < 4; ++r) { const float dec = __expf(gci2[it] - gcj2[jt][r]); const bool am = (jt < it) || (c >= 4 * g + r); av[r] = am ? qk[r] * dec : 0.f; }
            Af[it][jt] = pack4(av); asm volatile("" : "+v"(Af[it][jt]));
        }
    }
    if constexpr (MODE != 2) {
    u32x2 Kc[4][4];
#pragma unroll
    for (int t = 0; t < 4; ++t) {
        f32x4 et;
#pragma unroll
        for (int r = 0; r < 4; ++r) et[r] = __expf(glast - gcj[t][r]);
        const int base_row = d ? 60 - 16 * t - 4 * g : 16 * t + 4 * g;
#pragma unroll
        for (int nt = 0; nt < 4; ++nt) { f32x4 v = unpack4(tr_read(KIMG + (base_row + (c >> 2)) * IMG_ROW + (16 * nt + 4 * (c & 3)) * 2)); if (d) v = (f32x4){v[3], v[2], v[1], v[0]}; Kc[t][nt] = pack4(v * et); }
    }
    if (MODE == 0) { if (lane == 0) F.MISC[16 + w] = __float_as_uint(__expf(glast)); }
    else { if (lane == 0) ((float*)(F.ws + WS_LDSC))[litem] = __expf(glast); }
    if (MODE == 0) __syncthreads();
    LAS unsigned char* PTw = F.lds + w * 16384; LAS unsigned char* RBw = PTw + 8192;
    unsigned char* PTgl = F.ws + WS_LPT + (size_t)litem * 8192; unsigned char* RBgl = F.ws + WS_LRB + (size_t)litem * 8192;
#pragma unroll
    for (int mt = 0; mt < 4; ++mt)
#pragma unroll
        for (int nt = 0; nt < 4; ++nt) {
            f32x4 r = mm(Kc[0][mt], Kc[1][mt], Xb[0][nt], Xb[1][nt], (f32x4){0.f, 0.f, 0.f, 0.f}); r = mm(Kc[2][mt], Kc[3][mt], Xb[2][nt], Xb[3][nt], r);
            if (MODE == 0) *(LAS u32x2*)(RBw + ((nt * 4 + mt) * 64 + lane) * 8) = pack4(r); else *(GAS u32x2*)(RBgl + ((nt * 4 + mt) * 64 + lane) * 8) = pack4(r);
        }
#pragma unroll
    for (int ct = 0; ct < 4; ++ct)
#pragma unroll
        for (int s = 0; s < 2; ++s) {
            u32x2 hlf[2];
#pragma unroll
            for (int e = 0; e < 2; ++e) { const int rt = 2 * s + e;
                f32x4 p = mm(neg4(Xb[0][4 + rt]), neg4(Xb[1][4 + rt]), Kc[0][ct], Kc[1][ct], (f32x4){0.f, 0.f, 0.f, 0.f}); p = mm(neg4(Xb[2][4 + rt]), neg4(Xb[3][4 + rt]), Kc[2][ct], Kc[3][ct], p);
                hlf[e] = pack4(p); }
            if (MODE == 0) *(LAS v4u*)(PTw + ((ct * 2 + s) * 64 + lane) * 16) = (v4u){hlf[0].x, hlf[0].y, hlf[1].x, hlf[1].y}; else *(GAS v4u*)(PTgl + ((ct * 2 + s) * 64 + lane) * 16) = (v4u){hlf[0].x, hlf[0].y, hlf[1].x, hlf[1].y};
        }
    }
    if constexpr (MODE == 1) { __syncthreads(); return; }
    u32x2 OLb[4][4];
#pragma unroll
    for (int mt = 0; mt < 4; ++mt)
#pragma unroll
        for (int it = 0; it < 4; ++it) {
            f32x4 a = mm(Xb[0][mt], Xb[1][mt], Af[it][0], it >= 1 ? Af[it][1] : Z2, (f32x4){0.f, 0.f, 0.f, 0.f});
            if (it >= 2) a = mm(Xb[2][mt], Xb[3][mt], Af[it][2], it >= 3 ? Af[it][3] : Z2, a);
            OLb[mt][it] = pack4(a); asm volatile("" : "+v"(OLb[mt][it]));
        }
    u32x2 QT[4][4];
#pragma unroll
    for (int it = 0; it < 4; ++it)
#pragma unroll
        for (int mt = 0; mt < 4; ++mt) {
            f32x4 a = unpack4(Qf[it][mt]) * __expf(gci2[it]);
            a = mm(neg4(Xb[0][4 + mt]), neg4(Xb[1][4 + mt]), Af[it][0], it >= 1 ? Af[it][1] : Z2, a);
            if (it >= 2) a = mm(neg4(Xb[2][4 + mt]), neg4(Xb[3][4 + mt]), Af[it][2], it >= 3 ? Af[it][3] : Z2, a);
            QT[it][mt] = pack4(a); asm volatile("" : "+v"(QT[it][mt]));
        }
    const int lane3 = lane_id_fresh(), g3 = lane3 >> 4, c3 = lane3 & 15;
    if constexpr (MODE == 0) {
    __syncthreads();
    {   const int ds = w >> 2, sg = w & 3;
        f32x4 S[4];
#pragma unroll
        for (int t = 0; t < 4; ++t) S[t] = (f32x4){0.f, 0.f, 0.f, 0.f};
#pragma unroll 1
        for (int st = 0; st < 4; ++st) {
            const int wsrc = ds * 4 + st; LAS unsigned char* PTs = F.lds + wsrc * 16384; LAS unsigned char* RBs = PTs + 8192 + sg * 2048;
            u32x2 rb[4];
#pragma unroll
            for (int mt = 0; mt < 4; ++mt) rb[mt] = *(const LAS u32x2*)(RBs + (mt * 64 + lane3) * 8);
            const float dsc = __uint_as_float(F.MISC[16 + wsrc]);
            const u32x2 s0 = pack4(S[0]), s1 = pack4(S[1]), s2 = pack4(S[2]), s3 = pack4(S[3]);
            const v4u B0 = (v4u){s0.x, s0.y, s1.x, s1.y}, B1 = (v4u){s2.x, s2.y, s3.x, s3.y};
            asm volatile("s_waitcnt lgkmcnt(0)" ::: "memory");
            *(LAS v4u*)(RBs + lane3 * 16) = B0; *(LAS v4u*)(RBs + 1024 + lane3 * 16) = B1;
            f32x4 Sn[4];
#pragma unroll
            for (int mt = 0; mt < 4; ++mt) {
                f32x4 a = unpack4(rb[mt]) + S[mt] * dsc;
                a = mmv(*(const LAS v4u*)(PTs + ((mt * 2 + 0) * 64 + lane3) * 16), B0, a);
                a = mmv(*(const LAS v4u*)(PTs + ((mt * 2 + 1) * 64 + lane3) * 16), B1, a);
                Sn[mt] = a;
            }
#pragma unroll
            for (int t = 0; t < 4; ++t) S[t] = Sn[t];
        }
        float* os = F.out + (size_t)MT * D + ((size_t)(b * 2 + ds) * 8 + h) * 4096;
#pragma unroll
        for (int t = 0; t < 4; ++t)
#pragma unroll
            for (int r = 0; r < 4; ++r) os[(16 * t + 4 * g3 + r) * 64 + 16 * sg + c3] = S[t][r];
    }
    __syncthreads();
    } else { __syncthreads(); }
    v4u SA[4][2];
#pragma unroll
    for (int mt = 0; mt < 4; ++mt) {
        if (MODE == 0) { LAS unsigned char* RBw2 = F.lds + w * 16384 + 8192; SA[mt][0] = *(const LAS v4u*)(RBw2 + mt * 2048 + lane3 * 16); SA[mt][1] = *(const LAS v4u*)(RBw2 + mt * 2048 + 1024 + lane3 * 16); }
        else { const unsigned char* SCg = F.ws + WS_LSC + (size_t)litem * 8192; SA[mt][0] = *(const GAS v4u*)(SCg + mt * 2048 + lane3 * 16); SA[mt][1] = *(const GAS v4u*)(SCg + mt * 2048 + 1024 + lane3 * 16); } }
    if (MODE == 0) __syncthreads();
    LAS unsigned char* OX = F.lds + cch * 16384;
    const bf16* Zs = (const bf16*)(F.ws + WS_Z); bf16* OA = (bf16*)(F.ws + WS_OA); const float* onorm = in_ptr(I_ONORM);
    if (d == 1) {
#pragma unroll
        for (int it = 0; it < 4; ++it) { const int tau = 63 - (16 * it + c3);
#pragma unroll
            for (int mt = 0; mt < 4; ++mt) {
                f32x4 o = mmv(SA[mt][0], (v4u){QT[it][0].x, QT[it][0].y, QT[it][1].x, QT[it][1].y}, unpack4(OLb[mt][it]));
                o = mmv(SA[mt][1], (v4u){QT[it][2].x, QT[it][2].y, QT[it][3].x, QT[it][3].y}, o);
                *(LAS f32x4*)(OX + ((mt * 64 + tau) * 4 + g3) * 16) = o; } }
    }
    __syncthreads();
    if (d == 0) {
#pragma unroll
        for (int it = 0; it < 4; ++it) {
            const int tau = 16 * it + c3; float ss = 0.f; f32x4 o[4];
#pragma unroll
            for (int mt = 0; mt < 4; ++mt) {
                o[mt] = mmv(SA[mt][0], (v4u){QT[it][0].x, QT[it][0].y, QT[it][1].x, QT[it][1].y}, unpack4(OLb[mt][it]));
                o[mt] = mmv(SA[mt][1], (v4u){QT[it][2].x, QT[it][2].y, QT[it][3].x, QT[it][3].y}, o[mt]);
                o[mt] += *(const LAS f32x4*)(OX + ((mt * 64 + tau) * 4 + g3) * 16);
                ss += (o[mt][0] * o[mt][0] + o[mt][1] * o[mt][1]) + (o[mt][2] * o[mt][2] + o[mt][3] * o[mt][3]); }
            ss = xor32_add(xor16_add(ss));
            const float rs = rsqrtf(ss * (1.f / 64.f) + EPSN);
            const size_t ro = (size_t)(crow0 + tau) * 512 + h * 64;
#pragma unroll
            for (int mt = 0; mt < 4; ++mt) { const int dv = 16 * mt + 4 * g3; const f32x4 on = *(const GAS f32x4*)(onorm + dv); const f32x4 zz = unpack4(*(const GAS u32x2*)(Zs + ro + dv));
                *(GAS u32x2*)(OA + ro + dv) = pack4(o[mt] * rs * on * zz); }
        }
    }
    __syncthreads();
}

__device__ __forceinline__ void latent_scan(Frame& F, int task) {
    const int lane = lane_id_fresh(), g = lane >> 4, c = lane & 15, sg = task & 3, seq = task >> 2, dir = seq & 1, bh = seq >> 1;
    const float* s0 = in_ptr(I_STATE) + ((size_t)((bh >> 3) * 2 + dir) * 8 + (bh & 7)) * 4096;
    f32x4 S[4];
#pragma unroll
    for (int t = 0; t < 4; ++t)
#pragma unroll
        for (int r = 0; r < 4; ++r) S[t][r] = s0[(16 * t + 4 * g + r) * 64 + 16 * sg + c];
    const unsigned char* PT = F.ws + WS_LPT + (size_t)seq * 32 * 8192 + lane * 16;
    const unsigned char* RB = F.ws + WS_LRB + (size_t)seq * 32 * 8192 + sg * 2048 + lane * 8;
    unsigned char* SC = F.ws + WS_LSC + (size_t)seq * 32 * 8192 + sg * 2048 + lane * 16;
    const float* DS = (const float*)(F.ws + WS_LDSC) + seq * 32;
    v4u A[4][2], An[4][2]; u32x2 rb[4], rbn[4]; float dsc, dscn;
#pragma unroll
    for (int mt = 0; mt < 4; ++mt) { rb[mt] = *(const GAS u32x2*)(RB + mt * 512); A[mt][0] = *(const GAS v4u*)(PT + (mt * 2 + 0) * 1024); A[mt][1] = *(const GAS v4u*)(PT + (mt * 2 + 1) * 1024); }
    dsc = DS[0];
#pragma unroll 1
    for (int st = 0; st < 32; ++st) {
        const int nx = st < 31 ? st + 1 : st;
#pragma unroll
        for (int mt = 0; mt < 4; ++mt) { rbn[mt] = *(const GAS u32x2*)(RB + (size_t)nx * 8192 + mt * 512); An[mt][0] = *(const GAS v4u*)(PT + (size_t)nx * 8192 + (mt * 2 + 0) * 1024); An[mt][1] = *(const GAS v4u*)(PT + (size_t)nx * 8192 + (mt * 2 + 1) * 1024); }
        dscn = DS[nx];
        const u32x2 s0p = pack4(S[0]), s1p = pack4(S[1]), s2p = pack4(S[2]), s3p = pack4(S[3]);
        const v4u B0 = (v4u){s0p.x, s0p.y, s1p.x, s1p.y}, B1 = (v4u){s2p.x, s2p.y, s3p.x, s3p.y};
        *(GAS v4u*)(SC + (size_t)st * 8192) = B0; *(GAS v4u*)(SC + (size_t)st * 8192 + 1024) = B1;
#pragma unroll
        for (int mt = 0; mt < 4; ++mt) { f32x4 a = unpack4(rb[mt]) + S[mt] * dsc; a = mmv(A[mt][0], B0, a); a = mmv(A[mt][1], B1, a); S[mt] = a; }
#pragma unroll
        for (int mt = 0; mt < 4; ++mt) { rb[mt] = rbn[mt]; A[mt][0] = An[mt][0]; A[mt][1] = An[mt][1]; }
        dsc = dscn;
    }
}
struct Args { const float* in[19]; float* out; unsigned char* ws; };
__global__ void __launch_bounds__(NWAVES * 64, 2) mega_fwd(Args args) {
    extern __shared__ __attribute__((aligned(16))) unsigned char lds[];
    Frame F;
    F.lds = (LAS unsigned char*)lds; F.MISC = (volatile LAS unsigned*)(F.lds + MISC_OFF);
    F.wave = __builtin_amdgcn_readfirstlane((int)threadIdx.x >> 6); F.lane = lane_id_fresh(); F.tid = F.wave * 64 + F.lane;
    F.G = gridDim.x; { const int bx = blockIdx.x; F.vcu = (F.G % 8 == 0) ? (bx % 8) * (F.G / 8) + bx / 8 : bx; }
    F.ws = args.ws; F.out = args.out; F.ctl = (gu32*)(args.ws + WS_CTL);
    for (int u = F.tid; u < (LDS_BYTES - LDSCTL_OFF) / 4; u += NWAVES * 64) ((LAS unsigned*)(F.lds + LDSCTL_OFF))[u] = 0u;
    __syncthreads();
    XcdBarrier bar = xcd_barrier_post((unsigned*)(F.ctl + CW_BAR), F.MISC + 8);
#define GRID_BAR() do { xcd_barrier(bar); F.lane = lane_id_fresh(); F.tid = F.wave * 64 + F.lane; } while (0)
    typedef pg8::bf16_t pb;
    p0_prologue(F); GRID_BAR();
    p1_norm_rows(F); GRID_BAR();
    { pg8::Gemm g{(const pb*)(F.ws + WS_H), (const pb*)(F.ws + WS_WIN), MT, N1P, D}; pg8::StaticOrder S; S.init(MT, N1P, F.G, (int)blockIdx.x);
      pg8::EpiG1 E{(pb*)(F.ws + WS_QKV), (pb*)(F.ws + WS_Z), (pb*)(F.ws + WS_CX), (pb*)(F.ws + WS_BG), (pb*)(F.ws + WS_GA), (pb*)(F.ws + WS_GB), (float*)(F.ws + WS_BA)};
      pg8::gemm_phase<pg8::EpiG1, pg8::StaticOrder, true, true>(F.lds + RING_OFF, g, S, E, F.wave); }
    GRID_BAR();
    delta_tile<0>(F, F.vcu);
    delta_tile<1>(F, F.vcu);
    GRID_BAR();
    if (F.wave == 0) latent_scan(F, F.vcu);
    F.lane = lane_id_fresh(); F.tid = F.wave * 64 + F.lane;
    ob_phase(F);
    GRID_BAR();
    delta_tile<2>(F, F.vcu);
    GRID_BAR();
    { pg8::Gemm g{(const pb*)(F.ws + WS_OA), (const pb*)(F.ws + WS_WBA), MT, D, 512}; pg8::StaticOrder S; S.init(MT, D, F.G, (int)blockIdx.x);
      pg8::EpiBr<0> E{(pb*)(F.ws + WS_M), (const pb*)(F.ws + WS_GA)};
      pg8::gemm_phase<pg8::EpiBr<0>, pg8::StaticOrder, true, true>(F.lds + RING_OFF, g, S, E, F.wave); }
    { pg8::Gemm g{(const pb*)(F.ws + WS_OB), (const pb*)(F.ws + WS_WBB), MT, D, 512}; pg8::StaticOrder S; S.init(MT, D, F.G, (int)blockIdx.x);
      pg8::EpiBr<1> E{(pb*)(F.ws + WS_M), (const pb*)(F.ws + WS_GB)};
      pg8::gemm_phase<pg8::EpiBr<1>, pg8::StaticOrder, true, true>(F.lds + RING_OFF, g, S, E, F.wave); }
    GRID_BAR();
    { pg8::Gemm g{(const pb*)(F.ws + WS_M), (const pb*)(F.ws + WS_WO), MT, D, D}; pg8::StaticOrder S; S.init(MT, D, F.G, (int)blockIdx.x);
      pg8::EpiF32 E{(float*)(F.ws + WS_MIX), D};
      pg8::gemm_phase<pg8::EpiF32, pg8::StaticOrder, true, true>(F.lds + RING_OFF, g, S, E, F.wave); }
    GRID_BAR();
    resnorm_phase(F); GRID_BAR();
    { pg8::Gemm g{(const pb*)(F.ws + WS_H), (const pb*)(F.ws + WS_WFI), MT, 2 * DFF, D}; pg8::StaticOrder S; S.init(MT, 2 * DFF, F.G, (int)blockIdx.x);
      pg8::EpiFfnIn E{(pb*)(F.ws + WS_ACT)};
      pg8::gemm_phase<pg8::EpiFfnIn, pg8::StaticOrder, true, true>(F.lds + RING_OFF, g, S, E, F.wave); }
    GRID_BAR();
    { pg8::Gemm g{(const pb*)(F.ws + WS_ACT), (const pb*)(F.ws + WS_WFO), MT, D, DFF}; pg8::StaticOrder S; S.init(MT, D, F.G, (int)blockIdx.x);
      pg8::EpiF32 E{(float*)(F.ws + WS_Y), D};
      pg8::gemm_phase<pg8::EpiF32, pg8::StaticOrder, true, true>(F.lds + RING_OFF, g, S, E, F.wave); }
    GRID_BAR();
    final_phase(F);
}

extern "C" void kernel_launch(void* const* d_in, const int* in_sizes, int n_in, void* d_out, int out_size, void* d_ws, size_t ws_size, hipStream_t stream) {
    static int grid = 0;
    if (grid == 0) {
        if (n_in != 19 || ws_size < WS_END) { fprintf(stderr, "kernel_launch: expected 19 inputs and >= %zu bytes of workspace; got %d, %zu\n", (size_t)WS_END, n_in, ws_size); grid = -1; return; }
        int dev = 0, cus = 0, per_cu = 0;
        if (hipGetDevice(&dev) != hipSuccess || hipDeviceGetAttribute(&cus, hipDeviceAttributeMultiprocessorCount, dev) != hipSuccess) { grid = -1; return; }
        if (hipFuncSetAttribute((const void*)mega_fwd, hipFuncAttributeMaxDynamicSharedMemorySize, LDS_BYTES) != hipSuccess) { fprintf(stderr, "kernel_launch: hipFuncSetAttribute failed\n"); grid = -1; return; }
        if (hipOccupancyMaxActiveBlocksPerMultiprocessor(&per_cu, (const void*)mega_fwd, NWAVES * 64, LDS_BYTES) != hipSuccess || per_cu < 1) fprintf(stderr, "kernel_launch: occupancy query reports %d blocks/CU\n", per_cu);
        (void)hipGetLastError();
        if (cus < 256) { fprintf(stderr, "kernel_launch: this kernel needs 256 CUs (one workgroup per CU, 256 workgroups); device has %d\n", cus); grid = -1; return; }
        grid = 256;
    }
    if (grid < 0) return;
    if (hipMemsetAsync((char*)d_ws + WS_CTL, 0, CTL_ZERO_BYTES, stream) != hipSuccess) { fprintf(stderr, "kernel_launch: memset failed\n"); return; }
    Args a{};
    for (int i = 0; i < 19; ++i) a.in[i] = (const float*)d_in[i];
    a.out = (float*)d_out; a.ws = (unsigned char*)d_ws;
    hipLaunchKernelGGL(mega_fwd, dim3(grid), dim3(NWAVES * 64), LDS_BYTES, stream, a);
}
```
